# Optimizing an MI355X kernel written in HIP

```python
import math
import jax, jax.numpy as jnp
from jax import lax
import numpy as np


D_MODEL = 2048
BATCH = 1
SEQ = 16384
DEPTH = 2

HEAD_DIM = 128
GRID_W = 64
Q_BLOCK = 128
ROPE_THETA = 10000.0
EPS = 1e-6
A_HEADS = 4
A_KV_HEADS = 2
B_HEADS = 4
B_NOPE = 128
B_ROPE = 64
B_V = HEAD_DIM
B_Q_RANK = 384
B_KV_RANK = 256
C_HEADS = 4
C_KV_HEADS = 2
WINDOW = 128
D_HEADS = 4
D_HALF = HEAD_DIM // 2
N_BUCKETS = 32
MAX_DISTANCE = 128
N_BIAS_HEADS = C_HEADS + D_HEADS
D_FF = 4 * D_MODEL
N_MOD = 6
SPLIT_SIZES = (A_HEADS * HEAD_DIM, A_KV_HEADS * HEAD_DIM, A_KV_HEADS * HEAD_DIM,
               B_Q_RANK, B_KV_RANK, B_ROPE,
               C_HEADS * HEAD_DIM, C_KV_HEADS * HEAD_DIM, C_KV_HEADS * HEAD_DIM,
               D_HEADS * HEAD_DIM, D_HEADS * HEAD_DIM, D_HEADS * HEAD_DIM)
IN_COLS = sum(SPLIT_SIZES)
SPLIT_POINTS = tuple(int(v) for v in np.cumsum(SPLIT_SIZES)[:-1])
MIX_WIDTH = (A_HEADS + B_HEADS + C_HEADS + D_HEADS) * HEAD_DIM

kernel_name = 'hybrid_parallel_head_group_encoder'


def _rms_norm(x, gain):
    xf = x.astype(jnp.float32)
    y = xf * lax.rsqrt(jnp.mean(xf * xf, axis=-1, keepdims=True) + EPS)
    return (y * gain.astype(jnp.float32)).astype(x.dtype)


def _rope_tables(pos, dim):
    inv = ROPE_THETA ** (-jnp.arange(0, dim, 2, dtype=jnp.float32) / dim)
    ang = pos.astype(jnp.float32)[:, None] * inv[None, :]
    ang = jnp.concatenate([ang, ang], axis=-1)
    return jnp.cos(ang), jnp.sin(ang)


def _apply_rope(x, cos, sin):
    xf = x.astype(jnp.float32)
    x1, x2 = jnp.split(xf, 2, axis=-1)
    rot = jnp.concatenate([-x2, x1], axis=-1)
    return (xf * cos + rot * sin).astype(x.dtype)


def _t5_bucket(rel):
    half = N_BUCKETS // 2
    max_exact = half // 2
    n = jnp.abs(rel)
    large = max_exact + (jnp.log(jnp.maximum(n, 1).astype(jnp.float32) / max_exact)
                         / math.log(MAX_DISTANCE / max_exact) * (half - max_exact)).astype(jnp.int32)
    large = jnp.minimum(large, half - 1)
    return jnp.where(rel > 0, half, 0) + jnp.where(n < max_exact, n, large)


def _split_heads(t, n):
    b, s, _ = t.shape
    return t.reshape(b, s, n, -1).transpose(0, 2, 1, 3)


def _dense_attention(q, k, v, scale):
    b, hq, s, dk = q.shape
    hkv, dv = k.shape[1], v.shape[-1]
    g = hq // hkv
    nb = s // Q_BLOCK
    qb = jnp.moveaxis(q.reshape(b, hkv, g, nb, Q_BLOCK, dk), 3, 0)

    def block(qi):
        logits = jnp.einsum('bhgqd,bhkd->bhgqk', qi, k).astype(jnp.float32) * scale
        p = jax.nn.softmax(logits, axis=-1).astype(v.dtype)
        return jnp.einsum('bhgqk,bhkd->bhgqd', p, v)

    o = lax.map(block, qb)
    return jnp.moveaxis(o, 0, 3).reshape(b, hq, s, dv)


def _window_attention(q, k, v, bias_table, sink):
    b, hq, s, d = q.shape
    hkv = k.shape[1]
    g = hq // hkv
    qbk = Q_BLOCK
    nb = s // qbk
    qb = q.reshape(b, hkv, g, nb, qbk, d)

    def band(t):
        tp = jnp.pad(t, ((0, 0), (0, 0), (qbk, qbk), (0, 0))).reshape(b, hkv, nb + 2, qbk, t.shape[-1])
        return jnp.concatenate([tp[:, :, :-2], tp[:, :, 1:-1], tp[:, :, 2:]], axis=3)

    kb, vb = band(k), band(v)
    logits = jnp.einsum('bhgnqd,bhnkd->bhgnqk', qb, kb).astype(jnp.float32) * (d ** -0.5)
    qi = jnp.arange(qbk)
    kj = jnp.arange(3 * qbk)
    rel = kj[None, :] - qbk - qi[:, None]
    bias = jnp.moveaxis(bias_table[_t5_bucket(rel)], -1, 0).astype(jnp.float32).reshape(hkv, g, 1, qbk, 3 * qbk)
    kpos = jnp.arange(nb)[:, None] * qbk - qbk + kj[None, :]
    valid = (jnp.abs(rel) <= WINDOW)[None] & ((kpos >= 0) & (kpos < s))[:, None, :]
    logits = jnp.where(valid, logits + bias, -jnp.inf)
    sink_col = jnp.broadcast_to(sink.astype(jnp.float32).reshape(1, hkv, g, 1, 1, 1), logits.shape[:-1] + (1,))
    p = jax.nn.softmax(jnp.concatenate([logits, sink_col], axis=-1), axis=-1)[..., :-1]
    o = jnp.einsum('bhgnqk,bhnkd->bhgnqd', p.astype(v.dtype), vb)
    return o.reshape(b, hq, s, d)


def _diff_attention(q1, q2, k1, k2, v, bias_table, lam):
    b, h, s, dk = q1.shape
    nb = s // Q_BLOCK
    scale = dk ** -0.5
    qb1 = jnp.moveaxis(q1.reshape(b, h, nb, Q_BLOCK, dk), 2, 0)
    qb2 = jnp.moveaxis(q2.reshape(b, h, nb, Q_BLOCK, dk), 2, 0)
    kpos = jnp.arange(s)

    def block(args):
        qi1, qi2, idx = args
        qpos = idx * Q_BLOCK + jnp.arange(Q_BLOCK)
        bias = jnp.moveaxis(bias_table[_t5_bucket(kpos[None, :] - qpos[:, None])], -1, 0).astype(jnp.float32)
        a1 = jax.nn.softmax(jnp.einsum('bhqd,bhkd->bhqk', qi1, k1).astype(jnp.float32) * scale + bias, axis=-1)
        a2 = jax.nn.softmax(jnp.einsum('bhqd,bhkd->bhqk', qi2, k2).astype(jnp.float32) * scale + bias, axis=-1)
        return jnp.einsum('bhqk,bhkd->bhqd', (a1 - lam * a2).astype(v.dtype), v)

    o = lax.map(block, (qb1, qb2, jnp.arange(nb)))
    return jnp.moveaxis(o, 0, 2).reshape(b, h, s, v.shape[-1])


def _mixer(h, w_in, a_q_norm, a_k_norm, b_q_norm, b_kv_norm, b_w_uq, b_w_ukv, c_sink,
           d_lambda, d_sub_norm, w_out, rel_bias, rope_row, rope_col, rope_seq, lam_init):
    b, s, _ = h.shape
    (a_q, a_k, a_v, b_cq, b_ckv, b_kr, c_q, c_k, c_v, d_q, d_k, d_v) = jnp.split(h @ w_in, SPLIT_POINTS, axis=-1)
    half = HEAD_DIM // 2

    def axial(t):
        return jnp.concatenate([_apply_rope(t[..., :half], *rope_row), _apply_rope(t[..., half:], *rope_col)], axis=-1)
    qa = axial(_rms_norm(_split_heads(a_q, A_HEADS), a_q_norm))
    ka = axial(_rms_norm(_split_heads(a_k, A_KV_HEADS), a_k_norm))
    out_a = _dense_attention(qa, ka, _split_heads(a_v, A_KV_HEADS), HEAD_DIM ** -0.5)

    qb = _split_heads(_rms_norm(b_cq, b_q_norm) @ b_w_uq, B_HEADS)
    qb = jnp.concatenate([qb[..., :B_NOPE], _apply_rope(qb[..., B_NOPE:], *rope_seq)], axis=-1)
    kvb = _split_heads(_rms_norm(b_ckv, b_kv_norm) @ b_w_ukv, B_HEADS)
    kr = _apply_rope(b_kr[:, None], *rope_seq)
    kb = jnp.concatenate([kvb[..., :B_NOPE], jnp.broadcast_to(kr, (b, B_HEADS, s, B_ROPE))], axis=-1)
    out_b = _dense_attention(qb, kb, kvb[..., B_NOPE:], (B_NOPE + B_ROPE) ** -0.5)

    out_c = _window_attention(_split_heads(c_q, C_HEADS), _split_heads(c_k, C_KV_HEADS),
                              _split_heads(c_v, C_KV_HEADS), rel_bias[:, :C_HEADS], c_sink)

    qd = _split_heads(d_q, D_HEADS)
    kd = _split_heads(d_k, D_HEADS)
    lf = d_lambda.astype(jnp.float32)
    lam = jnp.exp(jnp.sum(lf[0] * lf[1])) - jnp.exp(jnp.sum(lf[2] * lf[3])) + lam_init
    od = _diff_attention(qd[..., :D_HALF], qd[..., D_HALF:], kd[..., :D_HALF], kd[..., D_HALF:],
                         _split_heads(d_v, D_HEADS), rel_bias[:, C_HEADS:], lam)
    out_d = _rms_norm(od, d_sub_norm) * (1.0 - lam_init)

    o = jnp.concatenate([out_a, out_b, out_c, out_d], axis=1)
    return o.transpose(0, 2, 1, 3).reshape(b, s, MIX_WIDTH) @ w_out


def _sq_relu_mlp(h, w1, w2):
    return jnp.square(jax.nn.relu(h @ w1)) @ w2


def setup_inputs(seed: int = 0) -> dict:
    key = jax.random.key(seed)
    ks = jax.random.split(key, 21)

    def nrm(k, shape, scale):
        return jax.random.normal(k, shape, jnp.float32) * scale

    def gain(k, shape):
        return 1.0 + 0.02 * jax.random.normal(k, shape, jnp.float32)

    return {
        'x': nrm(ks[0], (BATCH, SEQ, D_MODEL), 1.0),
        'c': nrm(ks[1], (BATCH, D_MODEL), 1.0),
        'w_ada': nrm(ks[2], (DEPTH, D_MODEL, N_MOD * D_MODEL), 0.5 * D_MODEL ** -0.5),
        'b_ada': nrm(ks[3], (DEPTH, N_MOD * D_MODEL), 0.02),
        'norm1': gain(ks[4], (DEPTH, D_MODEL)),
        'w_in': nrm(ks[5], (DEPTH, D_MODEL, IN_COLS), D_MODEL ** -0.5),
        'a_q_norm': gain(ks[6], (DEPTH, HEAD_DIM)),
        'a_k_norm': gain(ks[7], (DEPTH, HEAD_DIM)),
        'b_q_norm': gain(ks[8], (DEPTH, B_Q_RANK)),
        'b_kv_norm': gain(ks[9], (DEPTH, B_KV_RANK)),
        'b_w_uq': nrm(ks[10], (DEPTH, B_Q_RANK, B_HEADS * (B_NOPE + B_ROPE)), B_Q_RANK ** -0.5),
        'b_w_ukv': nrm(ks[11], (DEPTH, B_KV_RANK, B_HEADS * (B_NOPE + B_V)), B_KV_RANK ** -0.5),
        'c_sink': nrm(ks[12], (DEPTH, C_HEADS), 1.0),
        'd_lambda': nrm(ks[13], (DEPTH, 4, D_HALF), 0.1),
        'd_sub_norm': gain(ks[14], (DEPTH, HEAD_DIM)),
        'w_out': nrm(ks[15], (DEPTH, MIX_WIDTH, D_MODEL), MIX_WIDTH ** -0.5),
        'norm2': gain(ks[16], (DEPTH, D_MODEL)),
        'w_ff1': nrm(ks[17], (DEPTH, D_MODEL, D_FF), D_MODEL ** -0.5),
        'w_ff2': nrm(ks[18], (DEPTH, D_FF, D_MODEL), D_FF ** -0.5),
        'rel_bias': nrm(ks[19], (N_BUCKETS, N_BIAS_HEADS), 0.5),
        'final_norm': gain(ks[20], (D_MODEL,)),
    }


def reference(x, c, w_ada, b_ada, norm1, w_in, a_q_norm, a_k_norm, b_q_norm, b_kv_norm,
              b_w_uq, b_w_ukv, c_sink, d_lambda, d_sub_norm, w_out, norm2, w_ff1, w_ff2,
              rel_bias, final_norm):
    s = x.shape[1]
    rows = s // GRID_W
    row_idx = jnp.repeat(jnp.arange(rows), GRID_W)
    col_idx = jnp.tile(jnp.arange(GRID_W), rows)
    half = HEAD_DIM // 2
    rope_row = _rope_tables(row_idx, half)
    rope_col = _rope_tables(col_idx, half)
    rope_seq = _rope_tables(jnp.arange(s), B_ROPE)
    cs = jax.nn.silu(c)
    for l in range(DEPTH):
        lam_init = 0.8 - 0.6 * math.exp(-0.3 * l)
        mod = cs @ w_ada[l] + b_ada[l]
        shift1, scale1, gate1, shift2, scale2, gate2 = jnp.split(mod[:, None, :], N_MOD, axis=-1)
        h = _rms_norm(x, norm1[l]) * (1 + scale1) + shift1
        x = x + gate1 * _mixer(h, w_in[l], a_q_norm[l], a_k_norm[l], b_q_norm[l], b_kv_norm[l],
                               b_w_uq[l], b_w_ukv[l], c_sink[l], d_lambda[l], d_sub_norm[l],
                               w_out[l], rel_bias, rope_row, rope_col, rope_seq, lam_init)
        h = _rms_norm(x, norm2[l]) * (1 + scale2) + shift2
        x = x + gate2 * _sq_relu_mlp(h, w_ff1[l], w_ff2[l])
    return _rms_norm(x, final_norm)
```

```cpp
#include <hip/hip_runtime.h>
#include <hip/hip_bf16.h>
#include <hip/hip_cooperative_groups.h>
#include <cstdio>
#include <cstdint>
namespace cg = cooperative_groups;

#define LAS __attribute__((address_space(3)))
typedef unsigned short bf16_t;
typedef short bf16x8 __attribute__((ext_vector_type(8)));
typedef short s16x4 __attribute__((ext_vector_type(4)));
typedef float f32x4 __attribute__((ext_vector_type(4)));
typedef float f32x2 __attribute__((ext_vector_type(2)));
typedef float f32x16 __attribute__((ext_vector_type(16)));
typedef unsigned u32x4 __attribute__((ext_vector_type(4)));
typedef unsigned u32x2 __attribute__((ext_vector_type(2)));

constexpr int SEQ = 16384, DM = 2048, DFF = 8192, INC = 4288, INP = 4352, NLAYER = 2;
constexpr int C_AQ = 0, C_AK = 512, C_AV = 768, C_BCQ = 1024, C_BCKV = 1408, C_BKR = 1664, C_CQ = 1728, C_CK = 2240, C_CV = 2496, C_DQ = 2752, C_DK = 3264, C_DV = 3776;
constexpr float LOG2E = 1.4426950408889634f;
constexpr float SC_A = 0.08838834764831845f * LOG2E;
constexpr float SC_B = 0.07216878364870323f * LOG2E;
constexpr float SC_D = 0.125f * LOG2E;
constexpr float EPS = 1e-6f;

constexpr size_t MiB = 1u << 20;
constexpr size_t WS_CTL = 0;
constexpr size_t WS_SMALL = 131072;
constexpr int SM_N1 = 0, SM_N2 = 4096, SM_FN = 8192, SM_AQ = 10240, SM_AK = 10496, SM_DS = 10752, SM_CS = 11008, SM_RB = 11024, SM_END = 11280;
constexpr size_t WS_BAR = 65536;
constexpr size_t WS_MOD = 1 * MiB;
constexpr size_t WS_TAB = 2 * MiB;
constexpr size_t WS_RS = 6 * MiB;
constexpr size_t WS_WIN = 8 * MiB;
constexpr size_t WS_WUQ = 42 * MiB;
constexpr size_t WS_WUKV = 44 * MiB;
constexpr size_t WS_WOUT = 46 * MiB;
constexpr size_t WS_WFF1 = 62 * MiB;
constexpr size_t WS_WFF2 = 126 * MiB;
constexpr size_t WS_H = 190 * MiB;
constexpr size_t WS_DSCR = 254 * MiB;
constexpr size_t WS_P = 288 * MiB;
constexpr size_t WS_QB = 424 * MiB;
constexpr size_t WS_KVB = 448 * MiB;
constexpr size_t WS_O = 480 * MiB;
constexpr size_t WS_HID = 288 * MiB;
constexpr size_t WS_END = 544 * MiB;

__device__ __forceinline__ int tid_of(int wave_s) { int l; asm volatile("v_mbcnt_lo_u32_b32 %0, -1, 0\n\tv_mbcnt_hi_u32_b32 %0, -1, %0" : "=v"(l)); return wave_s * 64 + l; }
__device__ __forceinline__ unsigned f2bf(float f) { unsigned u = __builtin_bit_cast(unsigned, f); return (u + 0x7fffu + ((u >> 16) & 1u)) >> 16; }
__device__ __forceinline__ unsigned pk2(float lo, float hi) { return f2bf(lo) | (f2bf(hi) << 16); }
__device__ __forceinline__ float bf2f(unsigned short b) { return __builtin_bit_cast(float, (unsigned)b << 16); }
__device__ __forceinline__ unsigned cvtpk(float lo, float hi) { unsigned r; asm volatile("v_cvt_pk_bf16_f32 %0, %1, %2" : "=v"(r) : "v"(lo), "v"(hi)); return r; }
template <int X> __device__ __forceinline__ float swz_xor(float v) { return __builtin_bit_cast(float, __builtin_amdgcn_ds_swizzle(__builtin_bit_cast(int, v), 0x1f | (X << 10))); }
__device__ __forceinline__ float half_sum(float v) {
    v += swz_xor<1>(v); v += swz_xor<2>(v); v += swz_xor<4>(v); v += swz_xor<8>(v); v += swz_xor<16>(v); return v;
}
__device__ __forceinline__ float wave_sum(float v) {
    v = half_sum(v);
    auto rr = __builtin_amdgcn_permlane32_swap(__float_as_uint(v), __float_as_uint(v), false, false);
    return __uint_as_float(rr[0]) + __uint_as_float(rr[1]);
}

namespace pg8 {
constexpr int BM = 256, BK = 64, HALF = 128, HTB = HALF * BK * 2, STAGE_BYTES = 8 * HTB, NXCD = 8, WGM = 8;
__host__ __device__ __forceinline__ int lds_byte(int r, int c) { const int st = (r >> 4) * 2 + (c >> 5), rr = r & 15, cc = c & 31, ob = rr * 64 + cc * 2; return st * 1024 + (ob ^ (((ob >> 9) & 1) << 5)); }
__host__ __device__ __forceinline__ void stage_rc(int b, int& R, int& C) { const int st = b / 1024, sb = b % 1024, swz = sb ^ (((sb >> 9) & 1) << 5); R = (st >> 1) * 16 + swz / 64; C = (st & 1) * 32 + (swz % 64) / 2; }
__host__ __device__ __forceinline__ int perm32(int rho) { const int n = rho >> 4, i = rho & 15; return 8 * (i >> 2) + 4 * n + (i & 3); }
struct Unit { int pm, pn; };
struct Gemm { const bf16_t* A; const bf16_t* Bt; int M, N, K, lda; };
struct StaticOrder {
    int nM, nN, nwg, G, c;
    __host__ __device__ void init(int M, int N, int G_, int c_) { nM = M / BM; nN = N / BM; nwg = nM * nN; G = G_; c = c_; }
    __host__ __device__ bool next(int i, Unit& u) const {
        const long L = (long)i * G + c; if (L >= nwg) return false;
        int wgid = (int)L; { const int q = nwg / NXCD, r = nwg % NXCD, xcd = wgid % NXCD, off = wgid / NXCD; wgid = (xcd < r ? xcd * (q + 1) : r * (q + 1) + (xcd - r) * q) + off; }
        const int nig = WGM * nN, gid = wgid / nig, fm = gid * WGM, gsz = (nM - fm) < WGM ? (nM - fm) : WGM;
        u.pm = fm + ((wgid % nig) % gsz); u.pn = (wgid % nig) / gsz; return true;
    }
};
template <int MODE> struct EpiBf16 {
    static constexpr bool PERM = true;
    bf16_t* O; int ldc; const float* rs; const f32x2* tab;
    __device__ __forceinline__ void operator()(const f32x4 (&acc)[2][2][4][2], const Unit& u, int wr, int wc, int fr, int fq) const {
        const int row0 = u.pm * BM + wr * 64 + fr; const int col0 = u.pn * BM + wc * 32 + 8 * fq;
        bool rot[2]; int i0[2];
#pragma unroll
        for (int bj = 0; bj < 2; ++bj) { const int cm = (col0 + bj * HALF) % 192; rot[bj] = (MODE == 3) && cm >= 128; i0[bj] = rot[bj] ? (cm - 128) >> 1 : 0; }
#pragma unroll
        for (int am = 0; am < 4; ++am) { const int ai = am >> 1;
            f32x4 t0[4][2], t1[4][2]; float rsv[2][4];
#pragma unroll
            for (int m = 2 * (am & 1); m < 2 * (am & 1) + 2; ++m) rsv[ai][m] = (MODE >= 2) ? rs[row0 + ai * HALF + m * 16] : 1.f;
            if (MODE == 3) {
#pragma unroll
                for (int m = 2 * (am & 1); m < 2 * (am & 1) + 2; ++m)
#pragma unroll
                    for (int bj = 0; bj < 2; ++bj) { const f32x4* tp = (const f32x4*)(tab + (size_t)(row0 + ai * HALF + m * 16) * 32 + i0[bj]); t0[m][bj] = tp[0]; t1[m][bj] = tp[1];
                        if (!rot[bj]) { t0[m][bj] = (f32x4){1.f, 0.f, 1.f, 0.f}; t1[m][bj] = t0[m][bj]; } }
                asm volatile("" ::: "memory");
            }
#pragma unroll
            for (int m = 2 * (am & 1); m < 2 * (am & 1) + 2; ++m) { const int row = row0 + ai * HALF + m * 16; bf16_t* rowp = O + (size_t)row * ldc + col0;
                const float rsvv = rsv[ai][m];
#pragma unroll
                for (int bj = 0; bj < 2; ++bj) { f32x4 v0 = acc[ai][bj][m][0], v1 = acc[ai][bj][m][1];
                    if (MODE == 1) {
#pragma unroll
                        for (int e = 0; e < 4; ++e) { float a = fmaxf(v0[e], 0.f), b = fmaxf(v1[e], 0.f); v0[e] = a * a; v1[e] = b * b; } }
                    if (MODE >= 2) { v0 = v0 * rsvv; v1 = v1 * rsvv; }
                    if (MODE == 3) { const f32x4 a0 = t0[m][bj], a1 = t1[m][bj]; f32x4 w0, w1;
                        w0[0] = v0[0] * a0[0] - v0[1] * a0[1]; w0[1] = v0[1] * a0[0] + v0[0] * a0[1]; w0[2] = v0[2] * a0[2] - v0[3] * a0[3]; w0[3] = v0[3] * a0[2] + v0[2] * a0[3];
                        w1[0] = v1[0] * a1[0] - v1[1] * a1[1]; w1[1] = v1[1] * a1[0] + v1[0] * a1[1]; w1[2] = v1[2] * a1[2] - v1[3] * a1[3]; w1[3] = v1[3] * a1[2] + v1[2] * a1[3];
                        v0 = w0; v1 = w1; }
                    u32x4 w; w.x = cvtpk(v0[0], v0[1]); w.y = cvtpk(v0[2], v0[3]); w.z = cvtpk(v1[0], v1[1]); w.w = cvtpk(v1[2], v1[3]);
                    *(u32x4*)(rowp + bj * HALF) = w; } }
            if (MODE >= 2) asm volatile("" ::: "memory");
        }
    }
};
struct EpiRes {
    static constexpr bool PERM = false;
    const float* res; float* out; const float* gate; int ldc;
    __device__ __forceinline__ void operator()(const f32x4 (&acc)[2][2][4][2], const Unit& u, int wr, int wc, int fr, int fq) const {
        const int col0 = u.pn * BM + wc * 32 + 4 * fq;
        f32x4 gv[2][2];
#pragma unroll
        for (int bj = 0; bj < 2; ++bj)
#pragma unroll
            for (int n = 0; n < 2; ++n) gv[bj][n] = *(const f32x4*)(gate + col0 + bj * HALF + n * 16);
#pragma unroll
        for (int ai = 0; ai < 2; ++ai) {
            f32x4 bs[4][2][2];
#pragma unroll
            for (int m = 0; m < 4; ++m) { const size_t off = (size_t)(u.pm * BM + ai * HALF + wr * 64 + m * 16 + fr) * ldc + col0;
#pragma unroll
                for (int bj = 0; bj < 2; ++bj)
#pragma unroll
                    for (int n = 0; n < 2; ++n) bs[m][bj][n] = *(const f32x4*)(res + off + bj * HALF + n * 16); }
            asm volatile("" ::: "memory");
#pragma unroll
            for (int m = 0; m < 4; ++m) { const size_t off = (size_t)(u.pm * BM + ai * HALF + wr * 64 + m * 16 + fr) * ldc + col0;
#pragma unroll
                for (int bj = 0; bj < 2; ++bj)
#pragma unroll
                    for (int n = 0; n < 2; ++n) *(f32x4*)(out + off + bj * HALF + n * 16) = bs[m][bj][n] + gv[bj][n] * acc[ai][bj][m][n]; }
            asm volatile("" ::: "memory");
        }
    }
};

template <class Epi>
__device__ __forceinline__ void gemm_phase(LAS unsigned char* lds, const Gemm g, const StaticOrder& S, const Epi& E, int wave_s) {
    int tid_ = tid_of(wave_s);
    const int tid = tid_, wid = __builtin_amdgcn_readfirstlane(tid >> 6), lane = tid & 63, wr = wid >> 2, wc = wid & 3, fr = lane & 15, fq = lane >> 4;
    const int K = g.K, nt = K / BK;
    unsigned voffA[2], voffB[2];
#pragma unroll
    for (int i = 0; i < 2; ++i) { int R, C; stage_rc(tid * 16 + i * 8192, R, C); const int Rb = Epi::PERM ? ((R & ~31) + perm32(R & 31)) : R;
        voffA[i] = (unsigned)(R * g.lda + C) * 2u; voffB[i] = (unsigned)(Rb * K + C) * 2u; }
    const size_t kstep = (size_t)(BK * 2);
    const size_t hstepA = (size_t)HALF * g.lda * 2, hstepB = (size_t)HALF * K * 2;
    const size_t tstepA = 2 * hstepA, tstepB = 2 * hstepB;
    const unsigned ldsw = (unsigned)wid * 1024u;
    const int aoff = lds_byte(wr * 64 + fr, fq * 8), boff = lds_byte(wc * 32 + fr, fq * 8);
#define PG8_SA(b, h) (((b) * 2 + (h)) * HTB)
#define PG8_SB(b, h) ((4 + (b) * 2 + (h)) * HTB)
#define PG8_STAGE(bufoff, gbase, voff) do { _Pragma("unroll") for (int _i = 0; _i < 2; ++_i) \
        __builtin_amdgcn_global_load_lds((const unsigned*)((const char*)(gbase) + (voff)[_i]), (LAS unsigned*)(lds + (bufoff) + ldsw + _i * 8192), 16, 0, 0); } while (0)
#define PG8_LDA(dst, b, h) do { _Pragma("unroll") for (int m = 0; m < 4; ++m) _Pragma("unroll") for (int k = 0; k < 2; ++k) dst[m][k] = *(const LAS bf16x8*)(lds + PG8_SA(b, h) + aoff + m * 2048 + k * 1024); } while (0)
#define PG8_LDB(dst, b, h) do { _Pragma("unroll") for (int n = 0; n < 2; ++n) _Pragma("unroll") for (int k = 0; k < 2; ++k) dst[n][k] = *(const LAS bf16x8*)(lds + PG8_SB(b, h) + boff + n * 2048 + k * 1024); } while (0)
#define PG8_MMA(ai, bj, At, Bt) do { __builtin_amdgcn_s_setprio(1); _Pragma("unroll") for (int m = 0; m < 4; ++m) _Pragma("unroll") for (int n = 0; n < 2; ++n) _Pragma("unroll") for (int k = 0; k < 2; ++k) \
        acc[ai][bj][m][n] = __builtin_amdgcn_mfma_f32_16x16x32_bf16(Bt[n][k], At[m][k], acc[ai][bj][m][n], 0, 0, 0); __builtin_amdgcn_s_setprio(0); } while (0)
#define PG8_WAIT_V(n) asm volatile("s_waitcnt vmcnt(" #n ")" ::: "memory")
#define PG8_WAIT_L(n) asm volatile("s_waitcnt lgkmcnt(" #n ")" ::: "memory")
#define PG8_BAR __builtin_amdgcn_s_barrier()
#define PG8_SCHED __builtin_amdgcn_sched_barrier(0)
    Unit cur, nxt; int ui = 0;
    if (!S.next(0, cur)) return;
    f32x4 acc[2][2][4][2];
#pragma unroll
    for (int a = 0; a < 2; ++a)
#pragma unroll
        for (int b = 0; b < 2; ++b)
#pragma unroll
            for (int m = 0; m < 4; ++m)
#pragma unroll
                for (int n = 0; n < 2; ++n) acc[a][b][m][n] = (f32x4){0.f, 0.f, 0.f, 0.f};
    bf16x8 At[4][2], B0[2][2], B1[2][2];
    const char* cA = (const char*)g.A + (size_t)cur.pm * tstepA; const char* cB = (const char*)g.Bt + (size_t)cur.pn * tstepB;
    PG8_STAGE(PG8_SB(0, 0), cB, voffB); PG8_STAGE(PG8_SB(0, 1), cB + hstepB, voffB); PG8_STAGE(PG8_SA(0, 0), cA, voffA); PG8_STAGE(PG8_SA(0, 1), cA + hstepA, voffA);
    if (wr == 1) PG8_BAR;
    PG8_WAIT_V(2); PG8_BAR;
    PG8_STAGE(PG8_SB(1, 0), cB + kstep, voffB); PG8_STAGE(PG8_SA(1, 0), cA + kstep, voffA); PG8_STAGE(PG8_SB(1, 1), cB + hstepB + kstep, voffB);
    PG8_WAIT_V(6); PG8_BAR;
    for (;;) {
        const bool has_next = S.next(ui + 1, nxt);
        const char* nA = has_next ? (const char*)g.A + (size_t)nxt.pm * tstepA : cA; const char* nB = has_next ? (const char*)g.Bt + (size_t)nxt.pn * tstepB : cB;
        for (int t = 0; t < nt; t += 2) {
            const bool last = (t == nt - 2);
            const char* a1 = cA + (size_t)(t + 1) * kstep;
            const char* a2 = last ? nA : cA + (size_t)(t + 2) * kstep; const char* b2 = last ? nB : cB + (size_t)(t + 2) * kstep;
            const char* a3 = a2 + kstep; const char* b3 = b2 + kstep;
            PG8_LDB(B0, 0, 0); PG8_LDB(B1, 0, 1); PG8_SCHED; PG8_LDA(At, 0, 0); PG8_STAGE(PG8_SA(1, 1), a1 + hstepA, voffA);
            PG8_WAIT_V(8); PG8_WAIT_L(0); PG8_BAR; PG8_MMA(0, 0, At, B0); PG8_MMA(0, 1, At, B1); PG8_BAR; PG8_SCHED;
            PG8_LDA(At, 0, 1); PG8_STAGE(PG8_SB(0, 0), b2, voffB); PG8_STAGE(PG8_SB(0, 1), b2 + hstepB, voffB); PG8_STAGE(PG8_SA(0, 0), a2, voffA);
            PG8_WAIT_V(8); PG8_WAIT_L(0); PG8_BAR; PG8_MMA(1, 0, At, B0); PG8_MMA(1, 1, At, B1); PG8_BAR; PG8_SCHED;
            PG8_LDB(B0, 1, 0); PG8_LDB(B1, 1, 1); PG8_SCHED; PG8_LDA(At, 1, 0); PG8_STAGE(PG8_SA(0, 1), a2 + hstepA, voffA);
            PG8_WAIT_V(8); PG8_WAIT_L(0); PG8_BAR; PG8_MMA(0, 0, At, B0); PG8_MMA(0, 1, At, B1); PG8_BAR; PG8_SCHED;
            PG8_LDA(At, 1, 1); PG8_STAGE(PG8_SB(1, 0), b3, voffB); PG8_STAGE(PG8_SB(1, 1), b3 + hstepB, voffB); PG8_STAGE(PG8_SA(1, 0), a3, voffA);
            PG8_WAIT_V(8); PG8_WAIT_L(0); PG8_BAR; PG8_MMA(1, 0, At, B0); PG8_MMA(1, 1, At, B1); PG8_BAR; PG8_SCHED;
        }
        if (wr == 0) PG8_BAR;
        { const int l2_ = tid_of(wave_s) & 63; E(acc, cur, wr, wc, l2_ & 15, l2_ >> 4); }
        if (!has_next) break;
#pragma unroll
        for (int a = 0; a < 2; ++a)
#pragma unroll
            for (int b = 0; b < 2; ++b)
#pragma unroll
                for (int m = 0; m < 4; ++m)
#pragma unroll
                    for (int n = 0; n < 2; ++n) acc[a][b][m][n] = (f32x4){0.f, 0.f, 0.f, 0.f};
        cur = nxt; cA = nA; cB = nB; ++ui;
        if (wr == 1) PG8_BAR;
    }
    PG8_WAIT_V(0);
    PG8_BAR;
#undef PG8_SA
#undef PG8_SB
#undef PG8_STAGE
#undef PG8_LDA
#undef PG8_LDB
#undef PG8_MMA
#undef PG8_WAIT_V
#undef PG8_WAIT_L
#undef PG8_BAR
#undef PG8_SCHED
}
}

namespace att {
constexpr int NW = 8, QBLK = 32, KVBLK = 64;
constexpr int SHM_V = KVBLK * 128 * 2;
constexpr int SHM_KMAX = KVBLK * 384;
constexpr int OFF_K = 0, OFF_V = 3 * SHM_KMAX, OFF_WS = OFF_V + 4 * SHM_V, OFF_LUT = OFF_WS + NW * 256, ATT_LDS = OFF_LUT + 2048;
constexpr float THR2 = 11.5f;
#define SBAR() __builtin_amdgcn_sched_barrier(0)
__device__ __forceinline__ int crow(int r, int hi) { return (r & 3) + 8 * (r >> 2) + 4 * hi; }
__device__ __forceinline__ int v_st(int k, int c) { const int kk = (k & ~0xC) | ((k & 4) << 1) | ((k & 8) >> 1); return ((kk >> 3) * 4 + (c >> 5)) * 512 + ((kk & 7) * 32 + (c & 31)) * 2; }
__device__ __forceinline__ int v_rd_base(int lane) { return ((lane & 3) << 3) | (((lane >> 2) & 3) << 6) | (((lane >> 4) & 1) << 5) | (((lane >> 5) & 1) << 8); }
constexpr int v_rd_off(int d0, int ks, int half) { return d0 * 512 + ks * 4096 + half * 2048; }
template <int OFF> __device__ __forceinline__ s16x4 tr_read(int vb) {
    s16x4 r; asm volatile("ds_read_b64_tr_b16 %0, %1 offset:%2" : "=&v"(r) : "v"(vb), "i"(OFF) : "memory"); return r;
}
template <int D0> __device__ __forceinline__ void pv_one(f32x16& od, int vb, bf16x8 pa0, bf16x8 pa1, bf16x8 pa2, bf16x8 pa3) {
    const s16x4 l0 = tr_read<v_rd_off(D0, 0, 0)>(vb), h0 = tr_read<v_rd_off(D0, 0, 1)>(vb), l1 = tr_read<v_rd_off(D0, 1, 0)>(vb), h1 = tr_read<v_rd_off(D0, 1, 1)>(vb);
    const s16x4 l2 = tr_read<v_rd_off(D0, 2, 0)>(vb), h2 = tr_read<v_rd_off(D0, 2, 1)>(vb), l3 = tr_read<v_rd_off(D0, 3, 0)>(vb), h3 = tr_read<v_rd_off(D0, 3, 1)>(vb);
    asm volatile("s_waitcnt lgkmcnt(0)" ::: "memory"); SBAR();
#define PK(L, H) (bf16x8){L[0], L[1], L[2], L[3], H[0], H[1], H[2], H[3]}
    od = __builtin_amdgcn_mfma_f32_32x32x16_bf16(pa0, PK(l0, h0), od, 0, 0, 0);
    od = __builtin_amdgcn_mfma_f32_32x32x16_bf16(pa1, PK(l1, h1), od, 0, 0, 0);
    od = __builtin_amdgcn_mfma_f32_32x32x16_bf16(pa2, PK(l2, h2), od, 0, 0, 0);
    od = __builtin_amdgcn_mfma_f32_32x32x16_bf16(pa3, PK(l3, h3), od, 0, 0, 0);
#undef PK
}
template <bool RSM> __device__ __forceinline__ void pv_d0(f32x16* o, f32x16& lacc, int vb, bf16x8 pa0, bf16x8 pa1, bf16x8 pa2, bf16x8 pa3) {
    if (RSM) {
        const bf16x8 ones = {0x3F80, 0x3F80, 0x3F80, 0x3F80, 0x3F80, 0x3F80, 0x3F80, 0x3F80};
        lacc = __builtin_amdgcn_mfma_f32_32x32x16_bf16(pa0, ones, lacc, 0, 0, 0);
        lacc = __builtin_amdgcn_mfma_f32_32x32x16_bf16(pa1, ones, lacc, 0, 0, 0);
        lacc = __builtin_amdgcn_mfma_f32_32x32x16_bf16(pa2, ones, lacc, 0, 0, 0);
        lacc = __builtin_amdgcn_mfma_f32_32x32x16_bf16(pa3, ones, lacc, 0, 0, 0); }
    pv_one<0>(o[0], vb, pa0, pa1, pa2, pa3); pv_one<1>(o[1], vb, pa0, pa1, pa2, pa3); pv_one<2>(o[2], vb, pa0, pa1, pa2, pa3); pv_one<3>(o[3], vb, pa0, pa1, pa2, pa3);
}
template <int MODE, bool FIRST, bool FOLD>
__device__ __forceinline__ bool partialSM(f32x16& p0, f32x16& p1, float& m_reg, float& alpha, int relbase, bool near, const float* lut, float cb) {
    if (!FOLD) { const float off_ = cb - m_reg;
#pragma unroll
        for (int r = 0; r < 16; ++r) { p0[r] += off_; p1[r] += off_; } }
    if (MODE != 0 && near) {
#pragma unroll
        for (int r = 0; r < 16; ++r) { const int rel = relbase + (r & 3) + 8 * (r >> 2), rel1 = rel + 32;
            const int i0 = min(max(rel, -128), 128) + 128, i1 = min(max(rel1, -128), 128) + 128;
            const float b0 = lut[i0], b1 = lut[i1];
            if (MODE == 1) { p0[r] += b0; p1[r] += b1; }
            else { p0[r] = (rel >= -128 && rel <= 128) ? p0[r] + b0 : -1e30f; p1[r] = (rel1 >= -128 && rel1 <= 128) ? p1[r] + b1 : -1e30f; } }
    }
    float pmax = p0[0];
#pragma unroll
    for (int r = 1; r < 16; ++r) pmax = fmaxf(pmax, p0[r]);
#pragma unroll
    for (int r = 0; r < 16; ++r) pmax = fmaxf(pmax, p1[r]);
    { auto rr = __builtin_amdgcn_permlane32_swap(__float_as_uint(pmax), __float_as_uint(pmax), false, false);
      pmax = fmaxf(__uint_as_float(rr[0]), __uint_as_float(rr[1])); }
    bool resc;
    if (FIRST && MODE != 2) resc = true; else resc = __any(pmax > THR2);
    if (__builtin_expect(resc, FIRST && MODE != 2)) {
        const float delta = (FIRST && MODE != 2) ? pmax : fmaxf(pmax, 0.f);
        m_reg += delta; alpha = (FIRST && MODE != 2) ? 1.f : __builtin_amdgcn_exp2f(-delta);
#pragma unroll
        for (int r = 0; r < 16; ++r) { p0[r] -= delta; p1[r] -= delta; }
    } else alpha = 1.f;
#pragma unroll
    for (int r = 0; r < 16; ++r) p0[r] = __builtin_amdgcn_exp2f(p0[r]);
    return resc;
}
template <bool RSM> __device__ __forceinline__ void finishSM(f32x16& p0, f32x16& p1, float& l_reg, bf16x8& pa0, bf16x8& pa1, bf16x8& pa2, bf16x8& pa3) {
#pragma unroll
    for (int r = 0; r < 16; ++r) p1[r] = __builtin_amdgcn_exp2f(p1[r]);
    float ps = 0;
    if (!RSM) {
#pragma unroll
    for (int r = 0; r < 16; ++r) ps += p0[r];
#pragma unroll
    for (int r = 0; r < 16; ++r) ps += p1[r];
    { auto rr = __builtin_amdgcn_permlane32_swap(__float_as_uint(ps), __float_as_uint(ps), false, false);
      ps = __uint_as_float(rr[0]) + __uint_as_float(rr[1]); }
    l_reg += ps; }
#define PK4(P, BASE, OUT) do { u32x4 w = {cvtpk(P[BASE + 0], P[BASE + 1]), cvtpk(P[BASE + 2], P[BASE + 3]), cvtpk(P[BASE + 4], P[BASE + 5]), cvtpk(P[BASE + 6], P[BASE + 7])}; \
    OUT = *reinterpret_cast<bf16x8*>(&w); } while (0)
    PK4(p0, 0, pa0); PK4(p0, 8, pa1); PK4(p1, 0, pa2); PK4(p1, 8, pa3);
#undef PK4
}
template <int OFF> __device__ __forceinline__ bf16x8 lds_rd128(int addr) {
    bf16x8 r; asm volatile("ds_read_b128 %0, %1 offset:%2" : "=&v"(r) : "v"(addr), "i"(OFF) : "memory"); return r;
}
#define PK4X(P, BASE, OUT) do { u32x4 w = {cvtpk(P[BASE + 0], P[BASE + 1]), cvtpk(P[BASE + 2], P[BASE + 3]), cvtpk(P[BASE + 4], P[BASE + 5]), cvtpk(P[BASE + 6], P[BASE + 7])}; \
    OUT = *reinterpret_cast<bf16x8*>(&w); } while (0)
template <int S, bool RSM> __device__ __forceinline__ void fsm_step(f32x16& pc0, f32x16& pc1, float& ps, float& l_reg, bf16x8& pa0, bf16x8& pa1, bf16x8& pa2, bf16x8& pa3) {
    if (S < 4) {
#pragma unroll
        for (int r = 0; r < 4; ++r) pc1[4 * S + r] = __builtin_amdgcn_exp2f(pc1[4 * S + r]); }
    if (S == 4) { PK4X(pc0, 0, pa0); if (!RSM) ps = ((pc0[0] + pc0[1]) + (pc0[2] + pc0[3])) + ((pc0[4] + pc0[5]) + (pc0[6] + pc0[7])); }
    if (S == 5) { PK4X(pc0, 8, pa1); if (!RSM) ps += ((pc0[8] + pc0[9]) + (pc0[10] + pc0[11])) + ((pc0[12] + pc0[13]) + (pc0[14] + pc0[15])); }
    if (S == 6) { PK4X(pc1, 0, pa2); if (!RSM) ps += ((pc1[0] + pc1[1]) + (pc1[2] + pc1[3])) + ((pc1[4] + pc1[5]) + (pc1[6] + pc1[7])); }
    if (S == 7 && RSM) PK4X(pc1, 8, pa3);
    if (S == 7 && !RSM) { PK4X(pc1, 8, pa3); ps += ((pc1[8] + pc1[9]) + (pc1[10] + pc1[11])) + ((pc1[12] + pc1[13]) + (pc1[14] + pc1[15]));
        auto rr = __builtin_amdgcn_permlane32_swap(__float_as_uint(ps), __float_as_uint(ps), false, false); l_reg += __uint_as_float(rr[0]) + __uint_as_float(rr[1]); }
}
template <int NQ, int I> __device__ __forceinline__ void krd_pair(bf16x8& f0, bf16x8& f1, int ka, const int (&kb1)[2], const int (&kb2)[2]) {
    constexpr bool HAS1 = NQ >= 8; constexpr int SHM_K1 = HAS1 ? 16384 : 0, NP1 = HAS1 ? 8 : 0;
    if (I < NP1) { const int a_ = ka + kb1[0] + (((I < 8 ? I : 0) ^ kb1[1]) << 5); f0 = lds_rd128<0>(a_); f1 = lds_rd128<8192>(a_); }
    else { const int a_ = ka + kb2[0] + ((((I - NP1) & 3) ^ kb2[1]) << 5); f0 = lds_rd128<SHM_K1>(a_); f1 = lds_rd128<SHM_K1 + 4096>(a_); }
}
template <int NQ, int I> __device__ __forceinline__ void qk_slot(f32x16& pn0, f32x16& pn1, f32x16& pc0, f32x16& pc1, float& ps, float& l_reg, bf16x8& pa0, bf16x8& pa1, bf16x8& pa2, bf16x8& pa3,
                                                                   bf16x8 (&kf0)[3], bf16x8 (&kf1)[3], int ka, const int (&kb1)[2], const int (&kb2)[2], const bf16x8* qr, const f32x16& cinit) {
    constexpr int AH = (NQ == 8) ? 2 : 1, RING = AH + 1;
    if (I + AH < NQ) krd_pair<NQ, (I + AH < NQ ? I + AH : 0)>(kf0[(I + AH) % RING], kf1[(I + AH) % RING], ka, kb1, kb2);
    constexpr int LEFT = (NQ - 1 - I) < AH ? (NQ - 1 - I) : AH;
    if (LEFT == 2) asm volatile("s_waitcnt lgkmcnt(4)" ::: "memory"); else if (LEFT == 1) asm volatile("s_waitcnt lgkmcnt(2)" ::: "memory"); else asm volatile("s_waitcnt lgkmcnt(0)" ::: "memory");
    SBAR();
    if (I == 0) { pn0 = __builtin_amdgcn_mfma_f32_32x32x16_bf16(kf0[0], qr[0], cinit, 0, 0, 0); pn1 = __builtin_amdgcn_mfma_f32_32x32x16_bf16(kf1[0], qr[0], cinit, 0, 0, 0); }
    else { pn0 = __builtin_amdgcn_mfma_f32_32x32x16_bf16(kf0[I % RING], qr[I], pn0, 0, 0, 0); pn1 = __builtin_amdgcn_mfma_f32_32x32x16_bf16(kf1[I % RING], qr[I], pn1, 0, 0, 0); }
    if (NQ == 4) { fsm_step<2 * I, (NQ == 4)>(pc0, pc1, ps, l_reg, pa0, pa1, pa2, pa3); fsm_step<2 * I + 1, (NQ == 4)>(pc0, pc1, ps, l_reg, pa0, pa1, pa2, pa3); }
    else if (I < 8) fsm_step<(I < 8 ? I : 0), (NQ == 4)>(pc0, pc1, ps, l_reg, pa0, pa1, pa2, pa3);
    SBAR();
}
template <int NQ>
__device__ __forceinline__ void qk_fsm(f32x16& pn0, f32x16& pn1, f32x16& pc0, f32x16& pc1, float& l_reg, bf16x8& pa0, bf16x8& pa1, bf16x8& pa2, bf16x8& pa3,
                                       int ka, const int (&kb1)[2], const int (&kb2)[2], const bf16x8* qr, const f32x16& cinit, bf16x8 kfp0, bf16x8 kfp1) {
    bf16x8 kf0[3], kf1[3]; float ps = 0.f;
    if (NQ != 12) {
        kf0[0] = kfp0; kf1[0] = kfp1;
        asm volatile("" : "+v"(kf0[0]), "+v"(kf1[0]));
    }
    asm volatile("s_waitcnt lgkmcnt(0)" ::: "memory"); SBAR();
    if (NQ == 8) krd_pair<NQ, 1>(kf0[1], kf1[1], ka, kb1, kb2);
    if (NQ == 12) krd_pair<NQ, 0>(kf0[0], kf1[0], ka, kb1, kb2);
    qk_slot<NQ, 0>(pn0, pn1, pc0, pc1, ps, l_reg, pa0, pa1, pa2, pa3, kf0, kf1, ka, kb1, kb2, qr, cinit);
    qk_slot<NQ, 1>(pn0, pn1, pc0, pc1, ps, l_reg, pa0, pa1, pa2, pa3, kf0, kf1, ka, kb1, kb2, qr, cinit);
    qk_slot<NQ, 2>(pn0, pn1, pc0, pc1, ps, l_reg, pa0, pa1, pa2, pa3, kf0, kf1, ka, kb1, kb2, qr, cinit);
    qk_slot<NQ, 3>(pn0, pn1, pc0, pc1, ps, l_reg, pa0, pa1, pa2, pa3, kf0, kf1, ka, kb1, kb2, qr, cinit);
    if (NQ >= 8) {
        qk_slot<NQ, 4>(pn0, pn1, pc0, pc1, ps, l_reg, pa0, pa1, pa2, pa3, kf0, kf1, ka, kb1, kb2, qr, cinit);
        qk_slot<NQ, 5>(pn0, pn1, pc0, pc1, ps, l_reg, pa0, pa1, pa2, pa3, kf0, kf1, ka, kb1, kb2, qr, cinit);
        qk_slot<NQ, 6>(pn0, pn1, pc0, pc1, ps, l_reg, pa0, pa1, pa2, pa3, kf0, kf1, ka, kb1, kb2, qr, cinit);
        qk_slot<NQ, 7>(pn0, pn1, pc0, pc1, ps, l_reg, pa0, pa1, pa2, pa3, kf0, kf1, ka, kb1, kb2, qr, cinit); }
    if (NQ == 12) {
        qk_slot<NQ, 8>(pn0, pn1, pc0, pc1, ps, l_reg, pa0, pa1, pa2, pa3, kf0, kf1, ka, kb1, kb2, qr, cinit);
        qk_slot<NQ, 9>(pn0, pn1, pc0, pc1, ps, l_reg, pa0, pa1, pa2, pa3, kf0, kf1, ka, kb1, kb2, qr, cinit);
        qk_slot<NQ, 10>(pn0, pn1, pc0, pc1, ps, l_reg, pa0, pa1, pa2, pa3, kf0, kf1, ka, kb1, kb2, qr, cinit);
        qk_slot<NQ, 11>(pn0, pn1, pc0, pc1, ps, l_reg, pa0, pa1, pa2, pa3, kf0, kf1, ka, kb1, kb2, qr, cinit); }
}
template <int NQ>
__device__ __forceinline__ void qkt(f32x16& p0, f32x16& p1, const char* Ks, const int (&kq1)[2], const int (&kq2)[2], const bf16x8* qr, const f32x16& cinit) {
    int kb1[8], kb2[4];
#pragma unroll
    for (int i = 0; i < 8; ++i) kb1[i] = kq1[0] + ((i ^ kq1[1]) << 5);
#pragma unroll
    for (int i = 0; i < 4; ++i) kb2[i] = kq2[0] + ((i ^ kq2[1]) << 5);
    constexpr bool HAS1 = NQ >= 8, HAS2 = NQ != 8; constexpr int SHM_K1 = HAS1 ? 16384 : 0;
    p0 = cinit; p1 = cinit;
    if (HAS1) {
#pragma unroll
        for (int d0 = 0; d0 < 8; ++d0) { const char* a = Ks + kb1[d0];
            const bf16x8 b0 = *reinterpret_cast<const bf16x8*>(a); const bf16x8 b1 = *reinterpret_cast<const bf16x8*>(a + 8192);
            p0 = __builtin_amdgcn_mfma_f32_32x32x16_bf16(b0, qr[d0], p0, 0, 0, 0);
            p1 = __builtin_amdgcn_mfma_f32_32x32x16_bf16(b1, qr[d0], p1, 0, 0, 0); } }
    if (HAS2) {
#pragma unroll
        for (int d = 0; d < 4; ++d) { const char* a = Ks + SHM_K1 + kb2[d];
            const bf16x8 b0 = *reinterpret_cast<const bf16x8*>(a); const bf16x8 b1 = *reinterpret_cast<const bf16x8*>(a + 4096);
            p0 = __builtin_amdgcn_mfma_f32_32x32x16_bf16(b0, qr[(NQ == 12 ? 8 : 0) + d], p0, 0, 0, 0);
            p1 = __builtin_amdgcn_mfma_f32_32x32x16_bf16(b1, qr[(NQ == 12 ? 8 : 0) + d], p1, 0, 0, 0); } }
}
template <int NQ, int MODE>
__device__ __forceinline__ void attn_core(const bf16_t* __restrict__ Qb, int ldq, const bf16_t* __restrict__ K0, int ldk0, const bf16_t* __restrict__ K1, int ldk1,
                                          const bf16_t* __restrict__ Vh, int ldv, int kt0, int NT, int q0, const float* lut, float cbL, float cbR, float m_init, float l_init,
                                          char* lds, f32x16 (&o)[4], int wave_s) {
    constexpr bool HAS1 = NQ >= 8, HAS2 = NQ != 8;
    constexpr int SHM_K1 = HAS1 ? 16384 : 0, SHM_K2 = HAS2 ? 8192 : 0, SHM_KT = SHM_K1 + SHM_K2;
    constexpr int NLK = (HAS1 ? 2 : 0) + (HAS2 ? 1 : 0), NLV = 2, NL = NLK + NLV;
    constexpr bool FOLD = (NQ != 12 && MODE != 2);
    int tid_ = tid_of(wave_s);
    const int tid = tid_, wid = wave_s, lane = tid & 63, r32 = lane & 31, hi = lane >> 5;
    char* K_lds = lds + OFF_K; char* V_lds = lds + OFF_V;
    float* ws = (float*)(lds + OFF_WS) + wid * 64; float* li_l = ws; float* al_l = ws + 32;
    constexpr bool RSM = (NQ == 4);
    float m_reg = m_init, l_reg = l_init;
    f32x16 lacc;
#pragma unroll
    for (int r = 0; r < 16; ++r) lacc[r] = l_init;
#pragma unroll
    for (int d = 0; d < 4; ++d) o[d] = f32x16{};
    const int ldk2 = (NQ == 4) ? ldk0 : ldk1; const bf16_t* K2 = (NQ == 4) ? K0 : K1;
    unsigned voK1[2], voK2, voV[2];
#pragma unroll
    for (int i = 0; i < 2; ++i) { const int p = wid + 8 * i, row = 4 * p + (lane >> 4), cbs = (lane & 15) ^ (row & 15); voK1[i] = (unsigned)(row * ldk0 + cbs * 8) * 2u; }
    { const int row = 8 * wid + (lane >> 3), cbs = (lane & 7) ^ ((row >> 1) & 7); voK2 = (unsigned)(row * ldk2 + cbs * 8) * 2u; }
#pragma unroll
    for (int i = 0; i < 2; ++i) { const int p = wid + 8 * i, sub = 2 * p + (lane >> 5), kk = ((sub >> 2) << 3) | ((lane & 31) >> 2);
        const int k = kk, c = (sub & 3) * 32 + (lane & 3) * 8; voV[i] = (unsigned)(k * ldv + c) * 2u; }
    const char* gK1 = (const char*)(K0 + (size_t)kt0 * KVBLK * ldk0); const size_t stK1 = (size_t)KVBLK * ldk0 * 2;
    const char* gK2 = (const char*)(K2 + (size_t)kt0 * KVBLK * ldk2); const size_t stK2 = (size_t)KVBLK * ldk2 * 2;
    const char* gV = (const char*)(Vh + (size_t)kt0 * KVBLK * ldv); const size_t stV = (size_t)KVBLK * ldv * 2;
    LAS unsigned char* K3 = (LAS unsigned char*)K_lds; LAS unsigned char* V3 = (LAS unsigned char*)V_lds;
#define GLDS(g, l) __builtin_amdgcn_global_load_lds((const unsigned*)(g), (LAS unsigned*)(l), 16, 0, 0)
#define DMA_K(t, st) do { if (HAS1) { GLDS(gK1 + (size_t)(t) * stK1 + voK1[0], K3 + (st) * SHM_KT + wid * 1024); GLDS(gK1 + (size_t)(t) * stK1 + voK1[1], K3 + (st) * SHM_KT + (wid + 8) * 1024); } \
    if (HAS2) GLDS(gK2 + (size_t)(t) * stK2 + voK2, K3 + (st) * SHM_KT + SHM_K1 + wid * 1024); } while (0)
#define DMA_V(t, st) do { GLDS(gV + (size_t)(t) * stV + voV[0], V3 + (st) * SHM_V + wid * 1024); GLDS(gV + (size_t)(t) * stV + voV[1], V3 + (st) * SHM_V + (wid + 8) * 1024); } while (0)
#define WAIT_BAR(N) asm volatile("s_waitcnt vmcnt(" #N ") lgkmcnt(0)\n\ts_barrier" ::: "memory")
#define WAITB(n) do { if ((n) == 0) WAIT_BAR(0); else if ((n) == 1) WAIT_BAR(1); else if ((n) == 2) WAIT_BAR(2); else if ((n) == 3) WAIT_BAR(3); else if ((n) == 4) WAIT_BAR(4); else WAIT_BAR(5); } while (0)
    bf16x8 qr[NQ];
    const bf16_t* Qw = Qb + (long)(wid * QBLK + r32) * ldq + hi * 8;
    __syncthreads();
#pragma unroll
    for (int d0 = 0; d0 < NQ; ++d0) qr[d0] = *reinterpret_cast<const bf16x8*>(Qw + d0 * 16);
    DMA_K(0, 0); DMA_V(0, 0); DMA_K(1, 1);
    const int lo1 = (hi ^ (r32 & 1)) << 4, s3 = (r32 >> 1) & 7, b1_ = r32 * 256 + lo1;
    const int kb1[2] = {b1_, s3};
    const int lo2 = (hi ^ ((r32 >> 1) & 1)) << 4, s2 = (r32 >> 2) & 3, b2_ = r32 * 128 + lo2;
    const int kb2[2] = {b2_, s2};
    const int vb0 = (int)(uintptr_t)V_lds + v_rd_base(lane);
    const int kl0 = (int)(uintptr_t)K_lds;
    const int qw = q0 + wid * QBLK;
#define RESC(a, rs) do { if (rs) { if (hi == 0) al_l[r32] = (a); asm volatile("s_waitcnt lgkmcnt(0)" ::: "memory"); \
    _Pragma("unroll") for (int r = 0; r < 16; ++r) { const float al_ = al_l[crow(r, hi)]; if (RSM) lacc[r] *= al_; _Pragma("unroll") for (int d = 0; d < 4; ++d) o[d][r] *= al_; } } l_reg *= (a); } while (0)
#define TILEP(t) const int k0t = (kt0 + (t)) * KVBLK; const int relb = k0t - qw - r32 + 4 * hi; \
    const bool nearT = (MODE == 2) ? true : ((MODE == 1) ? !(k0t + 154 <= qw || k0t >= qw + 122) : false); \
    const float cbT = (MODE == 1 && !nearT) ? (k0t < qw ? cbL : cbR) : 0.f;
    f32x16 cinit = f32x16{}; float cur_cb = 0.f; bool dirty = true;
#define CINIT(t) do { TILEP(t); (void)relb; if (FOLD && (dirty || cbT != cur_cb)) { const float v_ = cbT - m_reg; _Pragma("unroll") for (int r = 0; r < 16; ++r) cinit[r] = v_; asm volatile("" : "+v"(cinit)); cur_cb = cbT; dirty = false; } } while (0)
    f32x16 pA0, pA1, pB0, pB1; float alA, alB; bool rsA, rsB; bf16x8 pa0, pa1, pa2, pa3;
    WAITB(NLK);
    if (2 < NT) DMA_K(2, 2); DMA_V(1, 1);
    CINIT(0);
    qkt<NQ>(pA0, pA1, K_lds, kb1, kb2, qr, cinit); { TILEP(0); (void)cbT; rsA = partialSM<MODE, true, FOLD>(pA0, pA1, m_reg, alA, relb, nearT, lut, cbT); dirty |= rsA; }
    l_reg *= alA;
    if (2 < NT) WAITB(NL); else WAITB(NLV);
#define grp1 (wid >= 4)
    int kc = 1, vp = 0;
#define KST(x) ((x) >= 3 ? (x) - 3 : (x))
#define VST(x) ((x) >= 4 ? (x) - 4 : (x))
    bf16x8 kfp0 = {}, kfp1 = {};
#define KPRE(st) do { if (NQ == 12) break; const char* kp_ = K_lds + (st) * SHM_KT; if (HAS1) { const int a_ = kb1[0] + (kb1[1] << 5); kfp0 = *reinterpret_cast<const bf16x8*>(kp_ + a_); kfp1 = *reinterpret_cast<const bf16x8*>(kp_ + a_ + 8192); } \
    else { const int a_ = kb2[0] + (kb2[1] << 5); kfp0 = *reinterpret_cast<const bf16x8*>(kp_ + a_); kfp1 = *reinterpret_cast<const bf16x8*>(kp_ + a_ + 4096); } SBAR(); } while (0)
#define EVENT(jj) do { const int n_ = (((jj) + 2 < NT) ? NLK : 0) + (((jj) + 1 < NT) ? NLV : 0); WAITB(n_); \
    if ((jj) + 3 < NT) DMA_K((jj) + 3, kc); if ((jj) + 2 < NT) DMA_V((jj) + 2, VST(vp + 3)); } while (0)
#define STEP(C0, C1, P0, P1, alC, rsC, jj) do { \
    SBAR(); qk_fsm<NQ>(C0, C1, P0, P1, l_reg, pa0, pa1, pa2, pa3, kl0 + kc * SHM_KT, kb1, kb2, qr, cinit, kfp0, kfp1); SBAR(); \
    if (grp1) EVENT(jj); \
    pv_d0<RSM>(o, lacc, vb0 + vp * SHM_V, pa0, pa1, pa2, pa3); \
    if (!grp1) EVENT(jj); \
    kc = KST(kc + 1); vp = VST(vp + 1); \
    KPRE(kc); \
    { TILEP(jj); (void)cbT; rsC = partialSM<MODE, false, FOLD>(C0, C1, m_reg, alC, relb, nearT, lut, cbT); dirty |= rsC; } \
    RESC(alC, rsC); CINIT((jj) + 1); } while (0)
    DMA_K(3, 0); DMA_V(2, 2);
    KPRE(kc); CINIT(1);
    for (int j = 1; j + 1 < NT; j += 2) {
        STEP(pB0, pB1, pA0, pA1, alB, rsB, j);
        STEP(pA0, pA1, pB0, pB1, alA, rsA, j + 1);
    }
    SBAR(); qk_fsm<NQ>(pB0, pB1, pA0, pA1, l_reg, pa0, pa1, pa2, pa3, kl0 + kc * SHM_KT, kb1, kb2, qr, cinit, kfp0, kfp1); SBAR();
    if (grp1) WAITB(0);
    pv_d0<RSM>(o, lacc, vb0 + vp * SHM_V, pa0, pa1, pa2, pa3);
    if (!grp1) WAITB(0);
    { TILEP(NT - 1); (void)cbT; rsB = partialSM<MODE, false, FOLD>(pB0, pB1, m_reg, alB, relb, nearT, lut, cbT); }
    RESC(alB, rsB);
    finishSM<RSM>(pB0, pB1, l_reg, pa0, pa1, pa2, pa3); SBAR();
    pv_d0<RSM>(o, lacc, vb0 + VST(vp + 1) * SHM_V, pa0, pa1, pa2, pa3);
    (void)alA;
    if (hi == 0) li_l[r32] = l_reg; asm volatile("s_waitcnt lgkmcnt(0)" ::: "memory");
#pragma unroll
    for (int r = 0; r < 16; ++r) { const float rl = __builtin_amdgcn_rcpf(RSM ? lacc[r] : li_l[crow(r, hi)]);
#pragma unroll
        for (int d = 0; d < 4; ++d) o[d][r] *= rl; }
#undef GLDS
#undef DMA_K
#undef DMA_V
#undef WAIT_BAR
#undef WAITB
#undef RESC
#undef TILEP
#undef CINIT
#undef KPRE
#undef EVENT
#undef STEP
#undef grp1
#undef KST
#undef VST
}
#undef SBAR
}


#define XB_TMO      128
#define XB_XCNT(j)  (256  + 64 * (j))
#define XB_XSUB(j)  (1280 + 64 * (j))
#define XB_XGEN(j)  (2304 + 64 * (j))
#define XB_TOP      3328
#define XB_TOPGEN   3392
#define XCD_BAR_WORDS 3456
#define XB_SPIN_CAP (1u << 22)
__device__ __forceinline__ unsigned xb_ld(unsigned* p)              { return __hip_atomic_load(p, __ATOMIC_RELAXED, __HIP_MEMORY_SCOPE_AGENT); }
__device__ __forceinline__ unsigned xb_add(unsigned* p, unsigned v) { return __hip_atomic_fetch_add(p, v, __ATOMIC_RELAXED, __HIP_MEMORY_SCOPE_AGENT); }
__device__ __forceinline__ unsigned xb_xcc_id() { return (unsigned)__builtin_amdgcn_s_getreg((3 << 11) | 20) & 0xFu; }
#define XB_SPIN(cond, bar) do { unsigned _sp = 0; while (cond) { __builtin_amdgcn_s_sleep(1); \
    if ((++_sp & 255u) == 0u) { if (xb_ld(&(bar)[XB_TMO])) break; if (_sp > XB_SPIN_CAP) { atomicAdd(&(bar)[XB_TMO], 1u); break; } } } } while (0)
struct XcdBarrier { unsigned* bar; unsigned x; volatile LAS unsigned* st; };
__device__ __forceinline__ XcdBarrier xcd_barrier_post(unsigned* bar, volatile LAS unsigned* st, bool tid0) {
    XcdBarrier b; b.bar = bar; b.x = xb_xcc_id(); b.st = st;
    if (tid0) (void)xb_add(&bar[XB_XCNT(b.x)], 1u);
    return b;
}
__device__ __forceinline__ void xcd_barrier_complete(unsigned* bar, unsigned x, unsigned& nloc, unsigned& nx) {
    const unsigned G = gridDim.x * gridDim.y * gridDim.z;
    unsigned sum, cnt, mine, sp = 0u;
    for (;;) {
        sum = 0u; cnt = 0u; mine = 0u;
#pragma unroll
        for (unsigned j = 0; j < 16; ++j) { const unsigned c = xb_ld(&bar[XB_XCNT(j)]); sum += c; cnt += (c > 0u) ? 1u : 0u; mine = (j == x) ? c : mine; }
        if (sum == G) break;
        __builtin_amdgcn_s_sleep(1);
        if ((++sp & 255u) == 0u) { if (xb_ld(&bar[XB_TMO])) break; if (sp > XB_SPIN_CAP) { atomicAdd(&bar[XB_TMO], 1u); break; } }
    }
    nloc = mine > 0u ? mine : 1u; nx = cnt > 0u ? cnt : 1u;
}
__device__ __forceinline__ void xcd_barrier(const XcdBarrier& b, int wave_s) {
    asm volatile("s_waitcnt vmcnt(0)" ::: "memory");
    __syncthreads();
    if (tid_of(wave_s) == 0) {
        unsigned* bar = b.bar;
        __builtin_amdgcn_s_waitcnt(0);
        unsigned nloc = b.st[0], nx = b.st[1];
        if (nloc == 0u) { xcd_barrier_complete(bar, b.x, nloc, nx); b.st[0] = nloc; b.st[1] = nx; }
        const unsigned old = xb_add(&bar[XB_XSUB(b.x)], 1u);
        const unsigned gen = old / nloc;
        if (old + 1u == (gen + 1u) * nloc) {
            __builtin_amdgcn_fence(__ATOMIC_RELEASE, "agent");
            asm volatile("s_waitcnt vmcnt(0)" ::: "memory");
            const unsigned og = xb_add(&bar[XB_TOP], 1u);
            const unsigned tg = og / nx;
            if (og + 1u == (tg + 1u) * nx) xb_add(&bar[XB_TOPGEN], 1u);
            else XB_SPIN(xb_ld(&bar[XB_TOPGEN]) == tg, bar);
            __builtin_amdgcn_fence(__ATOMIC_ACQUIRE, "agent");
            xb_add(&bar[XB_XGEN(b.x)], 1u);
            asm volatile("s_waitcnt vmcnt(0)" ::: "memory");
        } else {
            XB_SPIN(xb_ld(&bar[XB_XGEN(b.x)]) == gen, bar);
            __builtin_amdgcn_fence(__ATOMIC_ACQUIRE, "agent");
            asm volatile("s_waitcnt vmcnt(0)" ::: "memory");
        }
    }
    __syncthreads();
}

constexpr int NWAVES = 8, NTHR = 512;
constexpr int LDS_BYTES = 147456;
constexpr int MISC_OFF = 146432;
static_assert(att::ATT_LDS <= MISC_OFF && pg8::STAGE_BYTES <= MISC_OFF && MISC_OFF + 16 <= LDS_BYTES, "LDS map");

struct Args {
    const float* x; const float* c; const float* w_ada; const float* b_ada; const float* norm1; const float* w_in; const float* a_q_norm; const float* a_k_norm;
    const float* b_q_norm; const float* b_kv_norm; const float* b_w_uq; const float* b_w_ukv; const float* c_sink; const float* d_lambda; const float* d_sub_norm;
    const float* w_out; const float* norm2; const float* w_ff1; const float* w_ff2; const float* rel_bias; const float* final_norm;
    float* out; unsigned char* ws;
};

__device__ __forceinline__ int perm128(int p) { const int half = p >> 6, w = p & 63; return half * 64 + (w >> 1) + 32 * (w & 1); }
__device__ __forceinline__ int perm64(int p) { return (p >> 1) + 32 * (p & 1); }
template <int MAP> __device__ __forceinline__ int srcmap(int nd, float& sc) {
    sc = 1.f;
    if (MAP == 0) return nd;
    if (MAP == 1) {
        if (nd >= INC) return -1;
        if (nd < C_AV) return (nd & ~127) + perm128(nd & 127);
        if (nd >= C_BKR && nd < C_CQ) return C_BKR + perm64(nd - C_BKR);
        if (nd >= C_CQ && nd < C_CK) sc = SC_A;
        if (nd >= C_DQ && nd < C_DK) sc = SC_D;
        return nd;
    }
    sc = SC_B; const int hd = nd / 192, p = nd % 192;
    return p < 128 ? nd : hd * 192 + 128 + perm64(p - 128);
}
template <int MAP>
__device__ __forceinline__ void transpose_item(const float* W, int K, int N, int Npad, bf16_t* WT, const float* gk, LAS float* scr, int item, int lane) {
    const int nblk = Npad / 32, kb = item / nblk, nb = item % nblk, k0 = 64 * kb, n0 = 32 * nb;
    float sc; const int ns = srcmap<MAP>(n0 + (lane & 31), sc);
    float wv[32];
    const float* Wp = W + (size_t)(k0 + (lane >> 5)) * N + (ns >= 0 ? ns : 0);
#pragma unroll
    for (int i = 0; i < 32; ++i) wv[i] = Wp[(size_t)(2 * i) * N];
#pragma unroll
    for (int i = 0; i < 32; ++i) { const int kk = 2 * i + (lane >> 5); float v = ns >= 0 ? wv[i] : 0.f; if (gk) v *= gk[k0 + kk]; scr[kk * 33 + (lane & 31)] = v * sc; }
    asm volatile("s_waitcnt lgkmcnt(0)" ::: "memory");
    const int c = lane & 7;
#pragma unroll
    for (int j = 0; j < 4; ++j) { const int n = (lane >> 3) + 8 * j; const LAS float* s = scr + (8 * c) * 33 + n;
        u32x4 o; o.x = pk2(s[0 * 33], s[1 * 33]); o.y = pk2(s[2 * 33], s[3 * 33]); o.z = pk2(s[4 * 33], s[5 * 33]); o.w = pk2(s[6 * 33], s[7 * 33]);
        *(u32x4*)(WT + (size_t)(n0 + n) * K + k0 + 8 * c) = o; }
    asm volatile("s_waitcnt lgkmcnt(0)" ::: "memory");
}
__device__ __forceinline__ int t5_bucket(int rel) {
    const int n = rel < 0 ? -rel : rel;
    int b = n < 8 ? n : min(15, 2 + (31 - __clz(n * n)));
    return b + (rel > 0 ? 16 : 0);
}

template <bool FINAL>
__device__ __forceinline__ void norm_pass(const float* X, const float* g, const float* scale, const float* shift, bf16_t* H, float* OUTF, int vcu_, int NGW_, int wave_s) {
    int vcu = vcu_, NGW = NGW_; asm volatile("" : "+s"(vcu), "+s"(NGW));
    int tid_ = tid_of(wave_s);
    const int lane = tid_ & 63, gw = vcu * NWAVES + wave_s;
    f32x4 gm[8], sh[8];
#pragma unroll
    for (int j = 0; j < 8; ++j) { const f32x4 gv = ((const f32x4*)g)[64 * j + lane];
        if (!FINAL) { const f32x4 s = ((const f32x4*)scale)[64 * j + lane]; gm[j] = gv * (1.f + s); sh[j] = ((const f32x4*)shift)[64 * j + lane]; } else { gm[j] = gv; sh[j] = (f32x4){0.f, 0.f, 0.f, 0.f}; } }
    f32x4 nv[8];
    { const f32x4* xr = (const f32x4*)(X + (size_t)gw * DM) + lane;
#pragma unroll
        for (int j = 0; j < 8; ++j) nv[j] = xr[64 * j]; }
    for (int m = gw; m < SEQ; m += NGW) {
        f32x4 v[8]; float ss = 0.f;
#pragma unroll
        for (int j = 0; j < 8; ++j) v[j] = nv[j];
        if (m + NGW < SEQ) { const f32x4* xn = (const f32x4*)(X + (size_t)(m + NGW) * DM) + lane;
#pragma unroll
            for (int j = 0; j < 8; ++j) nv[j] = xn[64 * j]; }
#pragma unroll
        for (int j = 0; j < 8; ++j) ss += (v[j].x * v[j].x + v[j].y * v[j].y) + (v[j].z * v[j].z + v[j].w * v[j].w);
        const float rstd = 1.0f / sqrtf(wave_sum(ss) * (1.f / DM) + EPS);
        if (FINAL) { f32x4* orow = (f32x4*)(OUTF + (size_t)m * DM) + lane;
#pragma unroll
            for (int j = 0; j < 8; ++j) orow[64 * j] = v[j] * rstd * gm[j]; }
        else { u32x2* orow = (u32x2*)(H + (size_t)m * DM) + lane;
#pragma unroll
            for (int j = 0; j < 8; ++j) { const f32x4 y = v[j] * rstd * gm[j] + sh[j]; u32x2 w; w.x = pk2(y.x, y.y); w.y = pk2(y.z, y.w); orow[64 * j] = w; } }
    }
}


__device__ __forceinline__ void store_o_tile(const f32x16 (&o)[4], char* lds, bf16_t* Og, int wave_s) {
    int tid_ = tid_of(wave_s);
    const int wid = tid_ >> 6, lane = tid_ & 63, r32 = lane & 31, hi = lane >> 5;
    __syncthreads();
    bf16_t* stg = (bf16_t*)(lds + wid * 8192);
#pragma unroll
    for (int r = 0; r < 16; ++r) { const int orow = att::crow(r, hi);
#pragma unroll
        for (int d0 = 0; d0 < 4; ++d0) stg[orow * 128 + d0 * 32 + r32] = (bf16_t)f2bf(o[d0][r]); }
    asm volatile("s_waitcnt lgkmcnt(0)" ::: "memory");
#pragma unroll
    for (int i = 0; i < 8; ++i) { const int row = i * 4 + (lane >> 4), ch = lane & 15; const u32x4 v = *(const u32x4*)(stg + row * 128 + ch * 8); *(u32x4*)(Og + (size_t)row * DM + ch * 8) = v;
        if (i & 1) asm volatile("" ::: "memory"); }
    asm volatile("s_waitcnt lgkmcnt(0)" ::: "memory");
}

__global__ void __launch_bounds__(NTHR, 2) mega_fwd(Args a) {
    extern __shared__ __attribute__((aligned(16))) unsigned char lds[];
    cg::grid_group grid = cg::this_grid();
    const int wave_s = __builtin_amdgcn_readfirstlane((int)threadIdx.x >> 6);
    const int tid = tid_of(wave_s), lane = tid & 63, wave = wave_s;
    const int G = gridDim.x, bx = blockIdx.x;
    const int vcu = (G % 8 == 0) ? (bx % 8) * (G / 8) + bx / 8 : bx;
    const int gw = vcu * NWAVES + wave, NGW = G * NWAVES;
#define PH unsigned char* ws = a.ws; asm volatile("" : "+s"(ws)); int lq = l; asm volatile("" : "+s"(lq)); (void)lq;
#define LAM ((float*)(ws + WS_CTL))
#define SMV ((float*)(ws + WS_SMALL))
#define MOD ((float*)(ws + WS_MOD))
#define TAB ((f32x2*)(ws + WS_TAB))
#define RS ((float*)(ws + WS_RS))
#define WIN ((bf16_t*)(ws + WS_WIN))
#define WUQ ((bf16_t*)(ws + WS_WUQ))
#define WUKV ((bf16_t*)(ws + WS_WUKV))
#define WOUT ((bf16_t*)(ws + WS_WOUT))
#define WFF1 ((bf16_t*)(ws + WS_WFF1))
#define WFF2 ((bf16_t*)(ws + WS_WFF2))
#define H ((bf16_t*)(ws + WS_H))
#define DSCR ((float*)(ws + WS_DSCR))
#define P ((bf16_t*)(ws + WS_P))
#define QB ((bf16_t*)(ws + WS_QB))
#define KVB ((bf16_t*)(ws + WS_KVB))
#define O ((bf16_t*)(ws + WS_O))
#define HID ((bf16_t*)(ws + WS_HID))
    LAS unsigned char* ldsl = (LAS unsigned char*)lds;

    {
        const int l = 0; PH
        LAS float* scr = (LAS float*)(ldsl + wave * 16384);
        constexpr int I_IN = (DM / 64) * (INP / 32), I_UQ = (384 / 64) * (768 / 32), I_UKV = (256 / 64) * (1024 / 32), I_OUT = (DM / 64) * (DM / 32), I_F1 = (DM / 64) * (DFF / 32), I_F2 = (DFF / 64) * (DM / 32);
        constexpr int I_L = I_IN + I_UQ + I_UKV + I_OUT + I_F1 + I_F2;
        for (int it = gw; it < NLAYER * I_L; it += NGW) {
            const int l = it / I_L; int r = it % I_L;
            if (r < I_IN) { transpose_item<1>(a.w_in + (size_t)l * DM * INC, DM, INC, INP, WIN + (size_t)l * INP * DM, nullptr, scr, r, lane); continue; } r -= I_IN;
            if (r < I_UQ) { transpose_item<2>(a.b_w_uq + (size_t)l * 384 * 768, 384, 768, 768, WUQ + (size_t)l * 768 * 384, a.b_q_norm + l * 384, scr, r, lane); continue; } r -= I_UQ;
            if (r < I_UKV) { transpose_item<0>(a.b_w_ukv + (size_t)l * 256 * 1024, 256, 1024, 1024, WUKV + (size_t)l * 1024 * 256, a.b_kv_norm + l * 256, scr, r, lane); continue; } r -= I_UKV;
            if (r < I_OUT) { transpose_item<0>(a.w_out + (size_t)l * DM * DM, DM, DM, DM, WOUT + (size_t)l * DM * DM, nullptr, scr, r, lane); continue; } r -= I_OUT;
            if (r < I_F1) { transpose_item<0>(a.w_ff1 + (size_t)l * DM * DFF, DM, DFF, DFF, WFF1 + (size_t)l * DFF * DM, nullptr, scr, r, lane); continue; } r -= I_F1;
            transpose_item<0>(a.w_ff2 + (size_t)l * DFF * DM, DFF, DM, DM, WFF2 + (size_t)l * DM * DFF, nullptr, scr, r, lane);
        }
        for (int e = bx * NTHR + tid; e < SEQ * 32; e += G * NTHR) {
            const int pos = e >> 5, i = e & 31;
            const float inv = (float)exp2(-(double)i * (13.287712379549449 / 32.0));
            const float ang = (float)pos * inv;
            const double rev = (double)ang * 0.15915494309189535; const float fr = (float)(rev - rint(rev));
            TAB[e] = (f32x2){__builtin_amdgcn_cosf(fr), __builtin_amdgcn_sinf(fr)};
        }
        if (bx == 0) { float* sm = SMV;
            for (int i = tid; i < 4096; i += NTHR) { sm[SM_N1 + i] = a.norm1[i]; sm[SM_N2 + i] = a.norm2[i]; }
            for (int i = tid; i < 2048; i += NTHR) sm[SM_FN + i] = a.final_norm[i];
            if (tid < 256) { sm[SM_AQ + tid] = a.a_q_norm[tid]; sm[SM_AK + tid] = a.a_k_norm[tid]; sm[SM_DS + tid] = a.d_sub_norm[tid]; sm[SM_RB + tid] = a.rel_bias[tid]; }
            if (tid < 8) sm[SM_CS + tid] = a.c_sink[tid]; }
        if (bx == 0) for (int i = tid; i < XCD_BAR_WORDS; i += NTHR) ((unsigned*)(ws + WS_BAR))[i] = 0u;
        if (tid < 4) ((LAS unsigned*)(ldsl + MISC_OFF))[tid] = 0u;
        if (bx == 0 && wave == 0) {
            for (int l = 0; l < NLAYER; ++l) { const float* lf = a.d_lambda + l * 256;
                const float sa = wave_sum(lf[lane] * lf[64 + lane]), sb = wave_sum(lf[128 + lane] * lf[192 + lane]);
                const float lam_init = 0.8f - 0.6f * expf(-0.3f * (float)l);
                if (lane == 0) LAM[l] = expf(sa) - expf(sb) + lam_init; }
        }
        __syncthreads();
        LAS float* red = (LAS float*)ldsl;
        for (int ch = bx; ch < NLAYER * 192; ch += G) {
            const int l = ch / 192, n0 = (ch % 192) * 64; const float* W = a.w_ada + (size_t)l * DM * 12288;
            const int cg4 = lane & 15, ksub = lane >> 4; f32x4 acc = {0.f, 0.f, 0.f, 0.f};
#pragma unroll 16
            for (int kk = 0; kk < 64; ++kk) { const int k = wave * 256 + kk * 4 + ksub; const float cv = a.c[k]; const float sv = cv / (1.f + expf(-cv));
                const f32x4 w = *(const f32x4*)(W + (size_t)k * 12288 + n0 + cg4 * 4); acc += w * sv; }
#pragma unroll
            for (int e = 0; e < 4; ++e) { acc[e] += swz_xor<16>(acc[e]); auto rr = __builtin_amdgcn_permlane32_swap(__float_as_uint(acc[e]), __float_as_uint(acc[e]), false, false); acc[e] = __uint_as_float(rr[0]) + __uint_as_float(rr[1]); }
            if (ksub == 0) { red[wave * 64 + cg4 * 4 + 0] = acc[0]; red[wave * 64 + cg4 * 4 + 1] = acc[1]; red[wave * 64 + cg4 * 4 + 2] = acc[2]; red[wave * 64 + cg4 * 4 + 3] = acc[3]; }
            __syncthreads();
            if (tid < 64) { float s = 0.f;
#pragma unroll
                for (int w = 0; w < 8; ++w) s += red[w * 64 + tid];
                MOD[l * 12288 + n0 + tid] = s + a.b_ada[l * 12288 + n0 + tid]; }
            __syncthreads();
        }
    }
    grid.sync();
    (void)xcd_barrier_post((unsigned*)(a.ws + WS_BAR), (volatile LAS unsigned*)(ldsl + MISC_OFF), tid_of(wave_s) == 0);
#define GRID_BAR() do { unsigned char* wsb = a.ws; asm volatile("" : "+s"(wsb)); XcdBarrier xb_; xb_.bar = (unsigned*)(wsb + WS_BAR); xb_.x = xb_xcc_id(); xb_.st = (volatile LAS unsigned*)(ldsl + MISC_OFF); xcd_barrier(xb_, wave_s); } while (0)

    for (int l = 0; l < NLAYER; ++l) {
        const int tid = tid_of(wave_s), lane = tid & 63, wave = wave_s, gw = vcu * NWAVES + wave;
        { PH const float* mod = MOD + lq * 12288; norm_pass<false>((lq == 0) ? a.x : a.out, SMV + SM_N1 + lq * DM, mod + 1 * DM, mod + 0 * DM, H, nullptr, vcu, NGW, wave_s); }
        GRID_BAR();
        { PH pg8::Gemm g{H, WIN + (size_t)lq * INP * DM, SEQ, INP, DM, DM}; pg8::StaticOrder S; S.init(SEQ, INP, G, bx);
          pg8::EpiBf16<0> E{P, INP, nullptr, nullptr}; pg8::gemm_phase(ldsl, g, S, E, wave_s); }
        GRID_BAR();
        { PH
            const float* gq = SMV + SM_AQ + lq * 128; const float* gk = SMV + SM_AK + lq * 128;
            const int p0i = perm128(2 * lane), p1i = perm128(2 * lane + 1);
            const float gq0 = gq[p0i], gq1 = gq[p1i], gk0 = gk[p0i], gk1 = gk[p1i];
            for (int t = gw; t < SEQ; t += NGW) {
                bf16_t* row = P + (size_t)t * INP;
                unsigned w[12];
#pragma unroll
                for (int hd = 0; hd < 6; ++hd) w[hd] = ((const unsigned*)(row + hd * 128))[lane];
                w[6] = ((const unsigned*)(row + C_BKR))[lane & 31];
#pragma unroll
                for (int j = 0; j < 3; ++j) w[7 + j] = ((const unsigned*)(row + C_BCQ))[lane + 64 * j];
#pragma unroll
                for (int j = 0; j < 2; ++j) w[10 + j] = ((const unsigned*)(row + C_BCKV))[lane + 64 * j];
                const int pos = lane < 32 ? (t >> 6) : (t & 63); const f32x2 cs = TAB[pos * 32 + (lane & 31)], c2 = TAB[t * 32 + (lane & 31)];
#pragma unroll
                for (int hd = 0; hd < 6; ++hd) {
                    float x0 = bf2f((unsigned short)(w[hd] & 0xffff)), x1 = bf2f((unsigned short)(w[hd] >> 16));
                    const float rstd = 1.0f / sqrtf(wave_sum(x0 * x0 + x1 * x1) * (1.f / 128.f) + EPS);
                    const float qs = hd < 4 ? SC_A : 1.f;
                    x0 *= rstd * (hd < 4 ? gq0 : gk0) * qs; x1 *= rstd * (hd < 4 ? gq1 : gk1) * qs;
                    ((unsigned*)(row + hd * 128))[lane] = pk2(x0 * cs.x - x1 * cs.y, x1 * cs.x + x0 * cs.y); }
                if (lane < 32) { const float x0 = bf2f((unsigned short)(w[6] & 0xffff)), x1 = bf2f((unsigned short)(w[6] >> 16));
                    ((unsigned*)(row + C_BKR))[lane] = pk2(x0 * c2.x - x1 * c2.y, x1 * c2.x + x0 * c2.y); }
                float sq = 0.f, skv = 0.f;
#pragma unroll
                for (int j = 0; j < 3; ++j) { const float x0 = bf2f((unsigned short)(w[7 + j] & 0xffff)), x1 = bf2f((unsigned short)(w[7 + j] >> 16)); sq += x0 * x0 + x1 * x1; }
#pragma unroll
                for (int j = 0; j < 2; ++j) { const float x0 = bf2f((unsigned short)(w[10 + j] & 0xffff)), x1 = bf2f((unsigned short)(w[10 + j] >> 16)); skv += x0 * x0 + x1 * x1; }
                sq = wave_sum(sq); skv = wave_sum(skv);
                if (lane == 0) { RS[t] = 1.0f / sqrtf(sq * (1.f / 384.f) + EPS); RS[SEQ + t] = 1.0f / sqrtf(skv * (1.f / 256.f) + EPS); }
            }
        }
        GRID_BAR();
        { PH pg8::Gemm g{P + C_BCQ, WUQ + (size_t)lq * 768 * 384, SEQ, 768, 384, INP}; pg8::StaticOrder S; S.init(SEQ, 768, G, bx);
          pg8::EpiBf16<3> E{QB, 768, RS, TAB}; pg8::gemm_phase(ldsl, g, S, E, wave_s); }
        { PH pg8::Gemm g{P + C_BCKV, WUKV + (size_t)lq * 1024 * 256, SEQ, 1024, 256, INP}; pg8::StaticOrder S; S.init(SEQ, 1024, G, bx);
          pg8::EpiBf16<2> E{KVB, 1024, RS + SEQ, nullptr}; pg8::gemm_phase(ldsl, g, S, E, wave_s); }
        GRID_BAR();
        for (int u = vcu; u < 256; u += G) { PH
            const int hd = u >> 6, blk = u & 63, q0 = blk * 256;
            f32x16 o[4];
#define UNIT_IDS int tidu = tid_of(wave_s); const int wid = tidu >> 6, lane = tidu & 63, r32 = lane & 31, tid = tidu; (void)r32; (void)tid;
            float* lut = (float*)(lds + att::OFF_LUT);
            { UNIT_IDS att::attn_core<8, 0>(P + (size_t)q0 * INP + C_AQ + hd * 128, INP, P + C_AK + (hd >> 1) * 128, INP, nullptr, 0, P + C_AV + (hd >> 1) * 128, INP, 0, SEQ / 64, q0, nullptr, 0.f, 0.f, 0.f, 0.f, (char*)lds, o, wave_s);
              store_o_tile(o, (char*)lds, O + (size_t)(q0 + wid * 32) * DM + (0 + hd) * 128, wave_s); }
            { UNIT_IDS att::attn_core<12, 0>(QB + (size_t)q0 * 768 + hd * 192, 768, KVB + hd * 256, 1024, P + C_BKR, INP, KVB + hd * 256 + 128, 1024, 0, SEQ / 64, q0, nullptr, 0.f, 0.f, 0.f, 0.f, (char*)lds, o, wave_s);
              store_o_tile(o, (char*)lds, O + (size_t)(q0 + wid * 32) * DM + (4 + hd) * 128, wave_s); }
            { UNIT_IDS __syncthreads();
              if (tid < 257) lut[tid] = SMV[SM_RB + t5_bucket(tid - 128) * 8 + hd] * LOG2E;
              const int ks = q0 - 128 < 0 ? 0 : q0 - 128, ke = q0 + 384 > SEQ ? SEQ : q0 + 384;
              const float sink = SMV[SM_CS + lq * 4 + hd] * LOG2E;
              att::attn_core<8, 2>(P + (size_t)q0 * INP + C_CQ + hd * 128, INP, P + C_CK + (hd >> 1) * 128, INP, nullptr, 0, P + C_CV + (hd >> 1) * 128, INP, ks / 64, (ke - ks) / 64, q0, lut, 0.f, 0.f, sink, 1.f, (char*)lds, o, wave_s);
              store_o_tile(o, (char*)lds, O + (size_t)(q0 + wid * 32) * DM + (8 + hd) * 128, wave_s); }
            { UNIT_IDS __syncthreads();
              if (tid < 257) lut[tid] = SMV[SM_RB + t5_bucket(tid - 128) * 8 + 4 + hd] * LOG2E;
              const float cbL = SMV[SM_RB + 15 * 8 + 4 + hd] * LOG2E, cbR = SMV[SM_RB + 31 * 8 + 4 + hd] * LOG2E;
              att::attn_core<4, 1>(P + (size_t)q0 * INP + C_DQ + hd * 128, INP, P + C_DK + hd * 128, INP, nullptr, 0, P + C_DV + hd * 128, INP, 0, SEQ / 64, q0, lut, cbL, cbR, 0.f, 0.f, (char*)lds, o, wave_s);
              { float* scrp = DSCR + ((size_t)(u * 8 + wave_s) * 64) * 64 + (tid_of(wave_s) & 63);
#pragma unroll
              for (int d0 = 0; d0 < 4; ++d0)
#pragma unroll
                  for (int r = 0; r < 16; ++r) scrp[(d0 * 16 + r) * 64] = o[d0][r]; }
              att::attn_core<4, 1>(P + (size_t)q0 * INP + C_DQ + hd * 128 + 64, INP, P + C_DK + hd * 128 + 64, INP, nullptr, 0, P + C_DV + hd * 128, INP, 0, SEQ / 64, q0, lut, cbL, cbR, 0.f, 0.f, (char*)lds, o, wave_s);
              const int lane2 = tid_of(wave_s) & 63, r32b = lane2 & 31;
              const float* scrq = DSCR + ((size_t)(u * 8 + wave_s) * 64) * 64 + lane2; asm volatile("" : "+v"(scrq) :: "memory");
              const float lam = LAM[lq]; const float* gs = SMV + SM_DS + lq * 128; const float post = 1.f - (0.8f - 0.6f * expf(-0.3f * (float)lq));
              float gv[4];
#pragma unroll
              for (int d0 = 0; d0 < 4; ++d0) gv[d0] = gs[d0 * 32 + r32b] * post;
#pragma unroll
              for (int r = 0; r < 16; ++r) { float ss = 0.f;
#pragma unroll
                  for (int d0 = 0; d0 < 4; ++d0) { const float dv = scrq[(d0 * 16 + r) * 64] - lam * o[d0][r]; o[d0][r] = dv; ss += dv * dv; }
                  ss = half_sum(ss);
                  const float rstd = 1.0f / sqrtf(ss * (1.f / 128.f) + EPS);
#pragma unroll
                  for (int d0 = 0; d0 < 4; ++d0) o[d0][r] *= rstd * gv[d0];
                  if ((r & 3) == 3) asm volatile("" ::: "memory"); }
              store_o_tile(o, (char*)lds, O + (size_t)(q0 + wid * 32) * DM + (12 + hd) * 128, wave_s); }
        }
        GRID_BAR();
        { PH pg8::Gemm g{O, WOUT + (size_t)lq * DM * DM, SEQ, DM, DM, DM}; pg8::StaticOrder S; S.init(SEQ, DM, G, bx);
          pg8::EpiRes E{(lq == 0) ? a.x : a.out, a.out, MOD + lq * 12288 + 2 * DM, DM}; pg8::gemm_phase(ldsl, g, S, E, wave_s); }
        GRID_BAR();
        { PH const float* mod = MOD + lq * 12288; norm_pass<false>(a.out, SMV + SM_N2 + lq * DM, mod + 4 * DM, mod + 3 * DM, H, nullptr, vcu, NGW, wave_s); }
        GRID_BAR();
        { PH pg8::Gemm g{H, WFF1 + (size_t)lq * DFF * DM, SEQ, DFF, DM, DM}; pg8::StaticOrder S; S.init(SEQ, DFF, G, bx);
          pg8::EpiBf16<1> E{HID, DFF, nullptr, nullptr}; pg8::gemm_phase(ldsl, g, S, E, wave_s); }
        GRID_BAR();
        { PH pg8::Gemm g{HID, WFF2 + (size_t)lq * DM * DFF, SEQ, DM, DFF, DFF}; pg8::StaticOrder S; S.init(SEQ, DM, G, bx);
          pg8::EpiRes E{a.out, a.out, MOD + lq * 12288 + 5 * DM, DM}; pg8::gemm_phase(ldsl, g, S, E, wave_s); }
        GRID_BAR();
    }
    { const int l = 0; PH norm_pass<true>(a.out, SMV + SM_FN, nullptr, nullptr, nullptr, a.out, vcu, NGW, wave_s); }
}

extern "C" void kernel_launch(void* const* d_in, const int* in_sizes, int n_in, void* d_out, int out_size, void* d_ws, size_t ws_size, hipStream_t stream) {
    static int grid = 0;
    if (grid == 0) {
        if (n_in != 21 || out_size != SEQ * DM || ws_size < WS_END) { fprintf(stderr, "kernel_launch: unexpected shapes (n_in %d out %d ws %zu)\n", n_in, out_size, ws_size); grid = -1; return; }
        int dev = 0, cus = 0, per_cu = 0;
        hipGetDevice(&dev); hipDeviceGetAttribute(&cus, hipDeviceAttributeMultiprocessorCount, dev);
        if (hipFuncSetAttribute((const void*)mega_fwd, hipFuncAttributeMaxDynamicSharedMemorySize, LDS_BYTES) != hipSuccess) { fprintf(stderr, "kernel_launch: hipFuncSetAttribute failed\n"); grid = -1; return; }
        if (hipOccupancyMaxActiveBlocksPerMultiprocessor(&per_cu, (const void*)mega_fwd, NTHR, LDS_BYTES) != hipSuccess || per_cu < 1) { fprintf(stderr, "kernel_launch: occupancy query gave %d\n", per_cu); per_cu = 1; }
        (void)hipGetLastError();
        grid = cus * 1;
    }
    if (grid < 0) return;
    Args a{};
    const float** f = (const float**)&a;
    for (int i = 0; i < 21; ++i) f[i] = (const float*)d_in[i];
    a.out = (float*)d_out; a.ws = (unsigned char*)d_ws;
    void* args[] = {&a};
    hipError_t e = hipLaunchCooperativeKernel((const void*)mega_fwd, dim3(grid), dim3(NTHR), args, LDS_BYTES, stream);
    if (e != hipSuccess) fprintf(stderr, "cooperative launch failed: %s (grid %d)\n", hipGetErrorString(e), grid);
}
```

```cpp
#include <hip/hip_runtime.h>
#include <hip/hip_bf16.h>
#include <hip/hip_cooperative_groups.h>
#include <cstdio>
#include <cstdint>
namespace cg = cooperative_groups;

#define LAS __attribute__((address_space(3)))
typedef unsigned short bf16_t;
typedef short bf16x8 __attribute__((ext_vector_type(8)));
typedef short s16x4 __attribute__((ext_vector_type(4)));
typedef float f32x4 __attribute__((ext_vector_type(4)));
typedef float f32x2 __attribute__((ext_vector_type(2)));
typedef float f32x16 __attribute__((ext_vector_type(16)));
typedef unsigned u32x4 __attribute__((ext_vector_type(4)));
typedef unsigned u32x2 __attribute__((ext_vector_type(2)));

constexpr int SEQ = 16384, DM = 2048, DFF = 8192, INC = 4288, INP = 4352, NLAYER = 2;
constexpr int C_AQ = 0, C_AK = 512, C_AV = 768, C_BCQ = 1024, C_BCKV = 1408, C_BKR = 1664, C_CQ = 1728, C_CK = 2240, C_CV = 2496, C_DQ = 2752, C_DK = 3264, C_DV = 3776;
constexpr float LOG2E = 1.4426950408889634f;
constexpr float SC_A = 0.08838834764831845f * LOG2E;
constexpr float SC_B = 0.07216878364870323f * LOG2E;
constexpr float SC_D = 0.125f * LOG2E;
constexpr float EPS = 1e-6f;

constexpr size_t MiB = 1u << 20;
constexpr size_t WS_CTL = 0;
constexpr size_t WS_SMALL = 131072;
constexpr int SM_N1 = 0, SM_N2 = 4096, SM_FN = 8192, SM_AQ = 10240, SM_AK = 10496, SM_DS = 10752, SM_CS = 11008, SM_RB = 11024, SM_END = 11280;
constexpr size_t WS_BAR = 65536;
constexpr size_t WS_MOD = 1 * MiB;
constexpr size_t WS_TAB = 2 * MiB;
constexpr size_t WS_RS = 6 * MiB;
constexpr size_t WS_WIN = 8 * MiB;
constexpr size_t WS_WUQ = 42 * MiB;
constexpr size_t WS_WUKV = 44 * MiB;
constexpr size_t WS_WOUT = 46 * MiB;
constexpr size_t WS_WFF1 = 62 * MiB;
constexpr size_t WS_WFF2 = 126 * MiB;
constexpr size_t WS_H = 190 * MiB;
constexpr size_t WS_DSCR = 254 * MiB;
constexpr size_t WS_P = 288 * MiB;
constexpr size_t WS_QB = 424 * MiB;
constexpr size_t WS_KVB = 448 * MiB;
constexpr size_t WS_O = 480 * MiB;
constexpr size_t WS_HID = 288 * MiB;
constexpr size_t WS_END = 544 * MiB;

__device__ __forceinline__ int tid_of(int wave_s) { int l; asm volatile("v_mbcnt_lo_u32_b32 %0, -1, 0\n\tv_mbcnt_hi_u32_b32 %0, -1, %0" : "=v"(l)); return wave_s * 64 + l; }
__device__ __forceinline__ unsigned f2bf(float f) { unsigned u = __builtin_bit_cast(unsigned, f); return (u + 0x7fffu + ((u >> 16) & 1u)) >> 16; }
__device__ __forceinline__ unsigned pk2(float lo, float hi) { return f2bf(lo) | (f2bf(hi) << 16); }
__device__ __forceinline__ float bf2f(unsigned short b) { return __builtin_bit_cast(float, (unsigned)b << 16); }
__device__ __forceinline__ unsigned cvtpk(float lo, float hi) { unsigned r; asm volatile("v_cvt_pk_bf16_f32 %0, %1, %2" : "=v"(r) : "v"(lo), "v"(hi)); return r; }
template <int X> __device__ __forceinline__ float swz_xor(float v) { return __builtin_bit_cast(float, __builtin_amdgcn_ds_swizzle(__builtin_bit_cast(int, v), 0x1f | (X << 10))); }
__device__ __forceinline__ float half_sum(float v) {
    v += swz_xor<1>(v); v += swz_xor<2>(v); v += swz_xor<4>(v); v += swz_xor<8>(v); v += swz_xor<16>(v); return v;
}
__device__ __forceinline__ float wave_sum(float v) {
    v = half_sum(v);
    auto rr = __builtin_amdgcn_permlane32_swap(__float_as_uint(v), __float_as_uint(v), false, false);
    return __uint_as_float(rr[0]) + __uint_as_float(rr[1]);
}

namespace pg8 {
constexpr int BM = 256, BK = 64, HALF = 128, HTB = HALF * BK * 2, STAGE_BYTES = 8 * HTB, NXCD = 8, WGM = 8;
__host__ __device__ __forceinline__ int lds_byte(int r, int c) { const int st = (r >> 4) * 2 + (c >> 5), rr = r & 15, cc = c & 31, ob = rr * 64 + cc * 2; return st * 1024 + (ob ^ (((ob >> 9) & 1) << 5)); }
__host__ __device__ __forceinline__ void stage_rc(int b, int& R, int& C) { const int st = b / 1024, sb = b % 1024, swz = sb ^ (((sb >> 9) & 1) << 5); R = (st >> 1) * 16 + swz / 64; C = (st & 1) * 32 + (swz % 64) / 2; }
__host__ __device__ __forceinline__ int perm32(int rho) { const int n = rho >> 4, i = rho & 15; return 8 * (i >> 2) + 4 * n + (i & 3); }
struct Unit { int pm, pn; };
struct Gemm { const bf16_t* A; const bf16_t* Bt; int M, N, K, lda; };
struct StaticOrder {
    int nM, nN, nwg, G, c;
    __host__ __device__ void init(int M, int N, int G_, int c_) { nM = M / BM; nN = N / BM; nwg = nM * nN; G = G_; c = c_; }
    __host__ __device__ bool next(int i, Unit& u) const {
        const long L = (long)i * G + c; if (L >= nwg) return false;
        int wgid = (int)L; { const int q = nwg / NXCD, r = nwg % NXCD, xcd = wgid % NXCD, off = wgid / NXCD; wgid = (xcd < r ? xcd * (q + 1) : r * (q + 1) + (xcd - r) * q) + off; }
        const int nig = WGM * nN, gid = wgid / nig, fm = gid * WGM, gsz = (nM - fm) < WGM ? (nM - fm) : WGM;
        u.pm = fm + ((wgid % nig) % gsz); u.pn = (wgid % nig) / gsz; return true;
    }
};
template <int MODE> struct EpiBf16 {
    static constexpr bool PERM = true;
    bf16_t* O; int ldc; const float* rs; const f32x2* tab;
    __device__ __forceinline__ void operator()(const f32x4 (&acc)[2][2][4][2], const Unit& u, int wr, int wc, int fr, int fq) const {
        const int row0 = u.pm * BM + wr * 64 + fr; const int col0 = u.pn * BM + wc * 32 + 8 * fq;
        bool rot[2]; int i0[2];
#pragma unroll
        for (int bj = 0; bj < 2; ++bj) { const int cm = (col0 + bj * HALF) % 192; rot[bj] = (MODE == 3) && cm >= 128; i0[bj] = rot[bj] ? (cm - 128) >> 1 : 0; }
#pragma unroll
        for (int am = 0; am < 4; ++am) { const int ai = am >> 1;
            f32x4 t0[4][2], t1[4][2]; float rsv[2][4];
#pragma unroll
            for (int m = 2 * (am & 1); m < 2 * (am & 1) + 2; ++m) rsv[ai][m] = (MODE >= 2) ? rs[row0 + ai * HALF + m * 16] : 1.f;
            if (MODE == 3) {
#pragma unroll
                for (int m = 2 * (am & 1); m < 2 * (am & 1) + 2; ++m)
#pragma unroll
                    for (int bj = 0; bj < 2; ++bj) { const f32x4* tp = (const f32x4*)(tab + (size_t)(row0 + ai * HALF + m * 16) * 32 + i0[bj]); t0[m][bj] = tp[0]; t1[m][bj] = tp[1];
                        if (!rot[bj]) { t0[m][bj] = (f32x4){1.f, 0.f, 1.f, 0.f}; t1[m][bj] = t0[m][bj]; } }
                asm volatile("" ::: "memory");
            }
#pragma unroll
            for (int m = 2 * (am & 1); m < 2 * (am & 1) + 2; ++m) { const int row = row0 + ai * HALF + m * 16; bf16_t* rowp = O + (size_t)row * ldc + col0;
                const float rsvv = rsv[ai][m];
#pragma unroll
                for (int bj = 0; bj < 2; ++bj) { f32x4 v0 = acc[ai][bj][m][0], v1 = acc[ai][bj][m][1];
                    if (MODE == 1) {
#pragma unroll
                        for (int e = 0; e < 4; ++e) { float a = fmaxf(v0[e], 0.f), b = fmaxf(v1[e], 0.f); v0[e] = a * a; v1[e] = b * b; } }
                    if (MODE >= 2) { v0 = v0 * rsvv; v1 = v1 * rsvv; }
                    if (MODE == 3) { const f32x4 a0 = t0[m][bj], a1 = t1[m][bj]; f32x4 w0, w1;
                        w0[0] = v0[0] * a0[0] - v0[1] * a0[1]; w0[1] = v0[1] * a0[0] + v0[0] * a0[1]; w0[2] = v0[2] * a0[2] - v0[3] * a0[3]; w0[3] = v0[3] * a0[2] + v0[2] * a0[3];
                        w1[0] = v1[0] * a1[0] - v1[1] * a1[1]; w1[1] = v1[1] * a1[0] + v1[0] * a1[1]; w1[2] = v1[2] * a1[2] - v1[3] * a1[3]; w1[3] = v1[3] * a1[2] + v1[2] * a1[3];
                        v0 = w0; v1 = w1; }
                    u32x4 w; w.x = cvtpk(v0[0], v0[1]); w.y = cvtpk(v0[2], v0[3]); w.z = cvtpk(v1[0], v1[1]); w.w = cvtpk(v1[2], v1[3]);
                    *(u32x4*)(rowp + bj * HALF) = w; } }
            if (MODE >= 2) asm volatile("" ::: "memory");
        }
    }
};
struct EpiRes {
    static constexpr bool PERM = false;
    const float* res; float* out; const float* gate; int ldc;
    __device__ __forceinline__ void operator()(const f32x4 (&acc)[2][2][4][2], const Unit& u, int wr, int wc, int fr, int fq) const {
        const int col0 = u.pn * BM + wc * 32 + 4 * fq;
        f32x4 gv[2][2];
#pragma unroll
        for (int bj = 0; bj < 2; ++bj)
#pragma unroll
            for (int n = 0; n < 2; ++n) gv[bj][n] = *(const f32x4*)(gate + col0 + bj * HALF + n * 16);
#pragma unroll
        for (int ai = 0; ai < 2; ++ai) {
            f32x4 bs[4][2][2];
#pragma unroll
            for (int m = 0; m < 4; ++m) { const size_t off = (size_t)(u.pm * BM + ai * HALF + wr * 64 + m * 16 + fr) * ldc + col0;
#pragma unroll
                for (int bj = 0; bj < 2; ++bj)
#pragma unroll
                    for (int n = 0; n < 2; ++n) bs[m][bj][n] = *(const f32x4*)(res + off + bj * HALF + n * 16); }
            asm volatile("" ::: "memory");
#pragma unroll
            for (int m = 0; m < 4; ++m) { const size_t off = (size_t)(u.pm * BM + ai * HALF + wr * 64 + m * 16 + fr) * ldc + col0;
#pragma unroll
                for (int bj = 0; bj < 2; ++bj)
#pragma unroll
                    for (int n = 0; n < 2; ++n) *(f32x4*)(out + off + bj * HALF + n * 16) = bs[m][bj][n] + gv[bj][n] * acc[ai][bj][m][n]; }
            asm volatile("" ::: "memory");
        }
    }
};

template <class Epi>
__device__ __forceinline__ void gemm_phase(LAS unsigned char* lds, const Gemm g, const StaticOrder& S, const Epi& E, int wave_s) {
    int tid_ = tid_of(wave_s);
    const int tid = tid_, wid = __builtin_amdgcn_readfirstlane(tid >> 6), lane = tid & 63, wr = wid >> 2, wc = wid & 3, fr = lane & 15, fq = lane >> 4;
    const int K = g.K, nt = K / BK;
    unsigned voffA[2], voffB[2];
#pragma unroll
    for (int i = 0; i < 2; ++i) { int R, C; stage_rc(tid * 16 + i * 8192, R, C); const int Rb = Epi::PERM ? ((R & ~31) + perm32(R & 31)) : R;
        voffA[i] = (unsigned)(R * g.lda + C) * 2u; voffB[i] = (unsigned)(Rb * K + C) * 2u; }
    const size_t kstep = (size_t)(BK * 2);
    const size_t hstepA = (size_t)HALF * g.lda * 2, hstepB = (size_t)HALF * K * 2;
    const size_t tstepA = 2 * hstepA, tstepB = 2 * hstepB;
    const unsigned ldsw = (unsigned)wid * 1024u;
    const int aoff = lds_byte(wr * 64 + fr, fq * 8), boff = lds_byte(wc * 32 + fr, fq * 8);
#define PG8_SA(b, h) (((b) * 2 + (h)) * HTB)
#define PG8_SB(b, h) ((4 + (b) * 2 + (h)) * HTB)
#define PG8_STAGE(bufoff, gbase, voff) do { _Pragma("unroll") for (int _i = 0; _i < 2; ++_i) \
        __builtin_amdgcn_global_load_lds((const unsigned*)((const char*)(gbase) + (voff)[_i]), (LAS unsigned*)(lds + (bufoff) + ldsw + _i * 8192), 16, 0, 0); } while (0)
#define PG8_LDA(dst, b, h) do { _Pragma("unroll") for (int m = 0; m < 4; ++m) _Pragma("unroll") for (int k = 0; k < 2; ++k) dst[m][k] = *(const LAS bf16x8*)(lds + PG8_SA(b, h) + aoff + m * 2048 + k * 1024); } while (0)
#define PG8_LDB(dst, b, h) do { _Pragma("unroll") for (int n = 0; n < 2; ++n) _Pragma("unroll") for (int k = 0; k < 2; ++k) dst[n][k] = *(const LAS bf16x8*)(lds + PG8_SB(b, h) + boff + n * 2048 + k * 1024); } while (0)
#define PG8_MMA(ai, bj, At, Bt) do { __builtin_amdgcn_s_setprio(1); _Pragma("unroll") for (int m = 0; m < 4; ++m) _Pragma("unroll") for (int n = 0; n < 2; ++n) _Pragma("unroll") for (int k = 0; k < 2; ++k) \
        acc[ai][bj][m][n] = __builtin_amdgcn_mfma_f32_16x16x32_bf16(Bt[n][k], At[m][k], acc[ai][bj][m][n], 0, 0, 0); __builtin_amdgcn_s_setprio(0); } while (0)
#define PG8_WAIT_V(n) asm volatile("s_waitcnt vmcnt(" #n ")" ::: "memory")
#define PG8_WAIT_L(n) asm volatile("s_waitcnt lgkmcnt(" #n ")" ::: "memory")
#define PG8_BAR __builtin_amdgcn_s_barrier()
#define PG8_SCHED __builtin_amdgcn_sched_barrier(0)
    Unit cur, nxt; int ui = 0;
    if (!S.next(0, cur)) return;
    f32x4 acc[2][2][4][2];
#pragma unroll
    for (int a = 0; a < 2; ++a)
#pragma unroll
        for (int b = 0; b < 2; ++b)
#pragma unroll
            for (int m = 0; m < 4; ++m)
#pragma unroll
                for (int n = 0; n < 2; ++n) acc[a][b][m][n] = (f32x4){0.f, 0.f, 0.f, 0.f};
    bf16x8 At[4][2], B0[2][2], B1[2][2];
    const char* cA = (const char*)g.A + (size_t)cur.pm * tstepA; const char* cB = (const char*)g.Bt + (size_t)cur.pn * tstepB;
    PG8_STAGE(PG8_SB(0, 0), cB, voffB); PG8_STAGE(PG8_SB(0, 1), cB + hstepB, voffB); PG8_STAGE(PG8_SA(0, 0), cA, voffA); PG8_STAGE(PG8_SA(0, 1), cA + hstepA, voffA);
    if (wr == 1) PG8_BAR;
    PG8_WAIT_V(2); PG8_BAR;
    PG8_STAGE(PG8_SB(1, 0), cB + kstep, voffB); PG8_STAGE(PG8_SA(1, 0), cA + kstep, voffA); PG8_STAGE(PG8_SB(1, 1), cB + hstepB + kstep, voffB);
    PG8_WAIT_V(6); PG8_BAR;
    for (;;) {
        const bool has_next = S.next(ui + 1, nxt);
        const char* nA = has_next ? (const char*)g.A + (size_t)nxt.pm * tstepA : cA; const char* nB = has_next ? (const char*)g.Bt + (size_t)nxt.pn * tstepB : cB;
        for (int t = 0; t < nt; t += 2) {
            const bool last = (t == nt - 2);
            const char* a1 = cA + (size_t)(t + 1) * kstep;
            const char* a2 = last ? nA : cA + (size_t)(t + 2) * kstep; const char* b2 = last ? nB : cB + (size_t)(t + 2) * kstep;
            const char* a3 = a2 + kstep; const char* b3 = b2 + kstep;
            PG8_LDB(B0, 0, 0); PG8_LDB(B1, 0, 1); PG8_SCHED; PG8_LDA(At, 0, 0); PG8_STAGE(PG8_SA(1, 1), a1 + hstepA, voffA);
            PG8_WAIT_V(8); PG8_WAIT_L(0); PG8_BAR; PG8_MMA(0, 0, At, B0); PG8_MMA(0, 1, At, B1); PG8_BAR; PG8_SCHED;
            PG8_LDA(At, 0, 1); PG8_STAGE(PG8_SB(0, 0), b2, voffB); PG8_STAGE(PG8_SB(0, 1), b2 + hstepB, voffB); PG8_STAGE(PG8_SA(0, 0), a2, voffA);
            PG8_WAIT_V(8); PG8_WAIT_L(0); PG8_BAR; PG8_MMA(1, 0, At, B0); PG8_MMA(1, 1, At, B1); PG8_BAR; PG8_SCHED;
            PG8_LDB(B0, 1, 0); PG8_LDB(B1, 1, 1); PG8_SCHED; PG8_LDA(At, 1, 0); PG8_STAGE(PG8_SA(0, 1), a2 + hstepA, voffA);
            PG8_WAIT_V(8); PG8_WAIT_L(0); PG8_BAR; PG8_MMA(0, 0, At, B0); PG8_MMA(0, 1, At, B1); PG8_BAR; PG8_SCHED;
            PG8_LDA(At, 1, 1); PG8_STAGE(PG8_SB(1, 0), b3, voffB); PG8_STAGE(PG8_SB(1, 1), b3 + hstepB, voffB); PG8_STAGE(PG8_SA(1, 0), a3, voffA);
            PG8_WAIT_V(8); PG8_WAIT_L(0); PG8_BAR; PG8_MMA(1, 0, At, B0); PG8_MMA(1, 1, At, B1); PG8_BAR; PG8_SCHED;
        }
        if (wr == 0) PG8_BAR;
        { const int l2_ = tid_of(wave_s) & 63; E(acc, cur, wr, wc, l2_ & 15, l2_ >> 4); }
        if (!has_next) break;
#pragma unroll
        for (int a = 0; a < 2; ++a)
#pragma unroll
            for (int b = 0; b < 2; ++b)
#pragma unroll
                for (int m = 0; m < 4; ++m)
#pragma unroll
                    for (int n = 0; n < 2; ++n) acc[a][b][m][n] = (f32x4){0.f, 0.f, 0.f, 0.f};
        cur = nxt; cA = nA; cB = nB; ++ui;
        if (wr == 1) PG8_BAR;
    }
    PG8_WAIT_V(0);
    PG8_BAR;
#undef PG8_SA
#undef PG8_SB
#undef PG8_STAGE
#undef PG8_LDA
#undef PG8_LDB
#undef PG8_MMA
#undef PG8_WAIT_V
#undef PG8_WAIT_L
#undef PG8_BAR
#undef PG8_SCHED
}
}

namespace att {
constexpr int NW = 8, QBLK = 32, KVBLK = 64;
constexpr int SHM_V = KVBLK * 128 * 2;
constexpr int SHM_KMAX = KVBLK * 384;
constexpr int OFF_K = 0, OFF_V = 3 * SHM_KMAX, OFF_WS = OFF_V + 4 * SHM_V, OFF_LUT = OFF_WS + NW * 256, ATT_LDS = OFF_LUT + 2048;
constexpr float THR2 = 11.5f;
#define SBAR() __builtin_amdgcn_sched_barrier(0)
__device__ __forceinline__ int crow(int r, int hi) { return (r & 3) + 8 * (r >> 2) + 4 * hi; }
__device__ __forceinline__ int v_st(int k, int c) { const int kk = (k & ~0xC) | ((k & 4) << 1) | ((k & 8) >> 1); return ((kk >> 3) * 4 + (c >> 5)) * 512 + ((kk & 7) * 32 + (c & 31)) * 2; }
__device__ __forceinline__ int v_rd_base(int lane) { return ((lane & 3) << 3) | (((lane >> 2) & 3) << 6) | (((lane >> 4) & 1) << 5) | (((lane >> 5) & 1) << 8); }
constexpr int v_rd_off(int d0, int ks, int half) { return d0 * 512 + ks * 4096 + half * 2048; }
template <int OFF> __device__ __forceinline__ s16x4 tr_read(int vb) {
    s16x4 r; asm volatile("ds_read_b64_tr_b16 %0, %1 offset:%2" : "=&v"(r) : "v"(vb), "i"(OFF) : "memory"); return r;
}
template <int D0> __device__ __forceinline__ void pv_one(f32x16& od, int vb, bf16x8 pa0, bf16x8 pa1, bf16x8 pa2, bf16x8 pa3) {
    const s16x4 l0 = tr_read<v_rd_off(D0, 0, 0)>(vb), h0 = tr_read<v_rd_off(D0, 0, 1)>(vb), l1 = tr_read<v_rd_off(D0, 1, 0)>(vb), h1 = tr_read<v_rd_off(D0, 1, 1)>(vb);
    const s16x4 l2 = tr_read<v_rd_off(D0, 2, 0)>(vb), h2 = tr_read<v_rd_off(D0, 2, 1)>(vb), l3 = tr_read<v_rd_off(D0, 3, 0)>(vb), h3 = tr_read<v_rd_off(D0, 3, 1)>(vb);
    asm volatile("s_waitcnt lgkmcnt(0)" ::: "memory"); SBAR();
#define PK(L, H) (bf16x8){L[0], L[1], L[2], L[3], H[0], H[1], H[2], H[3]}
    od = __builtin_amdgcn_mfma_f32_32x32x16_bf16(pa0, PK(l0, h0), od, 0, 0, 0);
    od = __builtin_amdgcn_mfma_f32_32x32x16_bf16(pa1, PK(l1, h1), od, 0, 0, 0);
    od = __builtin_amdgcn_mfma_f32_32x32x16_bf16(pa2, PK(l2, h2), od, 0, 0, 0);
    od = __builtin_amdgcn_mfma_f32_32x32x16_bf16(pa3, PK(l3, h3), od, 0, 0, 0);
#undef PK
}
template <bool RSM> __device__ __forceinline__ void pv_d0(f32x16* o, f32x16& lacc, int vb, bf16x8 pa0, bf16x8 pa1, bf16x8 pa2, bf16x8 pa3) {
    if (RSM) {
        const bf16x8 ones = {0x3F80, 0x3F80, 0x3F80, 0x3F80, 0x3F80, 0x3F80, 0x3F80, 0x3F80};
        lacc = __builtin_amdgcn_mfma_f32_32x32x16_bf16(pa0, ones, lacc, 0, 0, 0);
        lacc = __builtin_amdgcn_mfma_f32_32x32x16_bf16(pa1, ones, lacc, 0, 0, 0);
        lacc = __builtin_amdgcn_mfma_f32_32x32x16_bf16(pa2, ones, lacc, 0, 0, 0);
        lacc = __builtin_amdgcn_mfma_f32_32x32x16_bf16(pa3, ones, lacc, 0, 0, 0); }
    pv_one<0>(o[0], vb, pa0, pa1, pa2, pa3); pv_one<1>(o[1], vb, pa0, pa1, pa2, pa3); pv_one<2>(o[2], vb, pa0, pa1, pa2, pa3); pv_one<3>(o[3], vb, pa0, pa1, pa2, pa3);
}
template <int MODE, bool FIRST, bool FOLD>
__device__ __forceinline__ bool partialSM(f32x16& p0, f32x16& p1, float& m_reg, float& alpha, int relbase, bool near, const float* lut, float cb) {
    if (!FOLD) { const float off_ = cb - m_reg;
#pragma unroll
        for (int r = 0; r < 16; ++r) { p0[r] += off_; p1[r] += off_; } }
    if (MODE != 0 && near) {
#pragma unroll
        for (int r = 0; r < 16; ++r) { const int rel = relbase + (r & 3) + 8 * (r >> 2), rel1 = rel + 32;
            const int i0 = min(max(rel, -128), 128) + 128, i1 = min(max(rel1, -128), 128) + 128;
            const float b0 = lut[i0], b1 = lut[i1];
            if (MODE == 1) { p0[r] += b0; p1[r] += b1; }
            else { p0[r] = (rel >= -128 && rel <= 128) ? p0[r] + b0 : -1e30f; p1[r] = (rel1 >= -128 && rel1 <= 128) ? p1[r] + b1 : -1e30f; } }
    }
    float pmax = p0[0];
#pragma unroll
    for (int r = 1; r < 16; ++r) pmax = fmaxf(pmax, p0[r]);
#pragma unroll
    for (int r = 0; r < 16; ++r) pmax = fmaxf(pmax, p1[r]);
    { auto rr = __builtin_amdgcn_permlane32_swap(__float_as_uint(pmax), __float_as_uint(pmax), false, false);
      pmax = fmaxf(__uint_as_float(rr[0]), __uint_as_float(rr[1])); }
    bool resc;
    if (FIRST && MODE != 2) resc = true; else resc = __any(pmax > THR2);
    if (__builtin_expect(resc, FIRST && MODE != 2)) {
        const float delta = (FIRST && MODE != 2) ? pmax : fmaxf(pmax, 0.f);
        m_reg += delta; alpha = (FIRST && MODE != 2) ? 1.f : __builtin_amdgcn_exp2f(-delta);
#pragma unroll
        for (int r = 0; r < 16; ++r) { p0[r] -= delta; p1[r] -= delta; }
    } else alpha = 1.f;
#pragma unroll
    for (int r = 0; r < 16; ++r) p0[r] = __builtin_amdgcn_exp2f(p0[r]);
    return resc;
}
template <bool RSM> __device__ __forceinline__ void finishSM(f32x16& p0, f32x16& p1, float& l_reg, bf16x8& pa0, bf16x8& pa1, bf16x8& pa2, bf16x8& pa3) {
#pragma unroll
    for (int r = 0; r < 16; ++r) p1[r] = __builtin_amdgcn_exp2f(p1[r]);
    float ps = 0;
    if (!RSM) {
#pragma unroll
    for (int r = 0; r < 16; ++r) ps += p0[r];
#pragma unroll
    for (int r = 0; r < 16; ++r) ps += p1[r];
    { auto rr = __builtin_amdgcn_permlane32_swap(__float_as_uint(ps), __float_as_uint(ps), false, false);
      ps = __uint_as_float(rr[0]) + __uint_as_float(rr[1]); }
    l_reg += ps; }
#define PK4(P, BASE, OUT) do { u32x4 w = {cvtpk(P[BASE + 0], P[BASE + 1]), cvtpk(P[BASE + 2], P[BASE + 3]), cvtpk(P[BASE + 4], P[BASE + 5]), cvtpk(P[BASE + 6], P[BASE + 7])}; \
    OUT = *reinterpret_cast<bf16x8*>(&w); } while (0)
    PK4(p0, 0, pa0); PK4(p0, 8, pa1); PK4(p1, 0, pa2); PK4(p1, 8, pa3);
#undef PK4
}
template <int OFF> __device__ __forceinline__ bf16x8 lds_rd128(int addr) {
    bf16x8 r; asm volatile("ds_read_b128 %0, %1 offset:%2" : "=&v"(r) : "v"(addr), "i"(OFF) : "memory"); return r;
}
#define PK4X(P, BASE, OUT) do { u32x4 w = {cvtpk(P[BASE + 0], P[BASE + 1]), cvtpk(P[BASE + 2], P[BASE + 3]), cvtpk(P[BASE + 4], P[BASE + 5]), cvtpk(P[BASE + 6], P[BASE + 7])}; \
    OUT = *reinterpret_cast<bf16x8*>(&w); } while (0)
template <int S, bool RSM> __device__ __forceinline__ void fsm_step(f32x16& pc0, f32x16& pc1, float& ps, float& l_reg, bf16x8& pa0, bf16x8& pa1, bf16x8& pa2, bf16x8& pa3) {
    if (S < 4) {
#pragma unroll
        for (int r = 0; r < 4; ++r) pc1[4 * S + r] = __builtin_amdgcn_exp2f(pc1[4 * S + r]); }
    if (S == 4) { PK4X(pc0, 0, pa0); if (!RSM) ps = ((pc0[0] + pc0[1]) + (pc0[2] + pc0[3])) + ((pc0[4] + pc0[5]) + (pc0[6] + pc0[7])); }
    if (S == 5) { PK4X(pc0, 8, pa1); if (!RSM) ps += ((pc0[8] + pc0[9]) + (pc0[10] + pc0[11])) + ((pc0[12] + pc0[13]) + (pc0[14] + pc0[15])); }
    if (S == 6) { PK4X(pc1, 0, pa2); if (!RSM) ps += ((pc1[0] + pc1[1]) + (pc1[2] + pc1[3])) + ((pc1[4] + pc1[5]) + (pc1[6] + pc1[7])); }
    if (S == 7 && RSM) PK4X(pc1, 8, pa3);
    if (S == 7 && !RSM) { PK4X(pc1, 8, pa3); ps += ((pc1[8] + pc1[9]) + (pc1[10] + pc1[11])) + ((pc1[12] + pc1[13]) + (pc1[14] + pc1[15]));
        auto rr = __builtin_amdgcn_permlane32_swap(__float_as_uint(ps), __float_as_uint(ps), false, false); l_reg += __uint_as_float(rr[0]) + __uint_as_float(rr[1]); }
}
template <int NQ, int I> __device__ __forceinline__ void krd_pair(bf16x8& f0, bf16x8& f1, int ka, const int (&kb1)[2], const int (&kb2)[2]) {
    constexpr bool HAS1 = NQ >= 8; constexpr int SHM_K1 = HAS1 ? 16384 : 0, NP1 = HAS1 ? 8 : 0;
    if (I < NP1) { const int a_ = ka + kb1[0] + (((I < 8 ? I : 0) ^ kb1[1]) << 5); f0 = lds_rd128<0>(a_); f1 = lds_rd128<8192>(a_); }
    else { const int a_ = ka + kb2[0] + ((((I - NP1) & 3) ^ kb2[1]) << 5); f0 = lds_rd128<SHM_K1>(a_); f1 = lds_rd128<SHM_K1 + 4096>(a_); }
}
template <int NQ, int I> __device__ __forceinline__ void qk_slot(f32x16& pn0, f32x16& pn1, f32x16& pc0, f32x16& pc1, float& ps, float& l_reg, bf16x8& pa0, bf16x8& pa1, bf16x8& pa2, bf16x8& pa3,
                                                                   bf16x8 (&kf0)[3], bf16x8 (&kf1)[3], int ka, const int (&kb1)[2], const int (&kb2)[2], const bf16x8* qr, const f32x16& cinit) {
    constexpr int AH = 1, RING = AH + 1;
    if (I + AH < NQ) krd_pair<NQ, (I + AH < NQ ? I + AH : 0)>(kf0[(I + AH) % RING], kf1[(I + AH) % RING], ka, kb1, kb2);
    constexpr int LEFT = (NQ - 1 - I) < AH ? (NQ - 1 - I) : AH;
    if (LEFT == 2) asm volatile("s_waitcnt lgkmcnt(4)" ::: "memory"); else if (LEFT == 1) asm volatile("s_waitcnt lgkmcnt(2)" ::: "memory"); else asm volatile("s_waitcnt lgkmcnt(0)" ::: "memory");
    SBAR();
    if (I == 0) { pn0 = __builtin_amdgcn_mfma_f32_32x32x16_bf16(kf0[0], qr[0], cinit, 0, 0, 0); pn1 = __builtin_amdgcn_mfma_f32_32x32x16_bf16(kf1[0], qr[0], cinit, 0, 0, 0); }
    else { pn0 = __builtin_amdgcn_mfma_f32_32x32x16_bf16(kf0[I % RING], qr[I], pn0, 0, 0, 0); pn1 = __builtin_amdgcn_mfma_f32_32x32x16_bf16(kf1[I % RING], qr[I], pn1, 0, 0, 0); }
    if (NQ == 4) { fsm_step<2 * I, (NQ == 4)>(pc0, pc1, ps, l_reg, pa0, pa1, pa2, pa3); fsm_step<2 * I + 1, (NQ == 4)>(pc0, pc1, ps, l_reg, pa0, pa1, pa2, pa3); }
    else if (I < 8) fsm_step<(I < 8 ? I : 0), (NQ == 4)>(pc0, pc1, ps, l_reg, pa0, pa1, pa2, pa3);
    SBAR();
}
template <int NQ>
__device__ __forceinline__ void qk_fsm(f32x16& pn0, f32x16& pn1, f32x16& pc0, f32x16& pc1, float& l_reg, bf16x8& pa0, bf16x8& pa1, bf16x8& pa2, bf16x8& pa3,
                                       int ka, const int (&kb1)[2], const int (&kb2)[2], const bf16x8* qr, const f32x16& cinit, bf16x8 kfp0, bf16x8 kfp1) {
    bf16x8 kf0[3], kf1[3]; float ps = 0.f;
    if (NQ != 12) {
        kf0[0] = kfp0; kf1[0] = kfp1;
        asm volatile("" : "+v"(kf0[0]), "+v"(kf1[0]));
    }
    asm volatile("s_waitcnt lgkmcnt(0)" ::: "memory"); SBAR();
    if (NQ == 12) krd_pair<NQ, 0>(kf0[0], kf1[0], ka, kb1, kb2);
    qk_slot<NQ, 0>(pn0, pn1, pc0, pc1, ps, l_reg, pa0, pa1, pa2, pa3, kf0, kf1, ka, kb1, kb2, qr, cinit);
    qk_slot<NQ, 1>(pn0, pn1, pc0, pc1, ps, l_reg, pa0, pa1, pa2, pa3, kf0, kf1, ka, kb1, kb2, qr, cinit);
    qk_slot<NQ, 2>(pn0, pn1, pc0, pc1, ps, l_reg, pa0, pa1, pa2, pa3, kf0, kf1, ka, kb1, kb2, qr, cinit);
    qk_slot<NQ, 3>(pn0, pn1, pc0, pc1, ps, l_reg, pa0, pa1, pa2, pa3, kf0, kf1, ka, kb1, kb2, qr, cinit);
    if (NQ >= 8) {
        qk_slot<NQ, 4>(pn0, pn1, pc0, pc1, ps, l_reg, pa0, pa1, pa2, pa3, kf0, kf1, ka, kb1, kb2, qr, cinit);
        qk_slot<NQ, 5>(pn0, pn1, pc0, pc1, ps, l_reg, pa0, pa1, pa2, pa3, kf0, kf1, ka, kb1, kb2, qr, cinit);
        qk_slot<NQ, 6>(pn0, pn1, pc0, pc1, ps, l_reg, pa0, pa1, pa2, pa3, kf0, kf1, ka, kb1, kb2, qr, cinit);
        qk_slot<NQ, 7>(pn0, pn1, pc0, pc1, ps, l_reg, pa0, pa1, pa2, pa3, kf0, kf1, ka, kb1, kb2, qr, cinit); }
    if (NQ == 12) {
        qk_slot<NQ, 8>(pn0, pn1, pc0, pc1, ps, l_reg, pa0, pa1, pa2, pa3, kf0, kf1, ka, kb1, kb2, qr, cinit);
        qk_slot<NQ, 9>(pn0, pn1, pc0, pc1, ps, l_reg, pa0, pa1, pa2, pa3, kf0, kf1, ka, kb1, kb2, qr, cinit);
        qk_slot<NQ, 10>(pn0, pn1, pc0, pc1, ps, l_reg, pa0, pa1, pa2, pa3, kf0, kf1, ka, kb1, kb2, qr, cinit);
        qk_slot<NQ, 11>(pn0, pn1, pc0, pc1, ps, l_reg, pa0, pa1, pa2, pa3, kf0, kf1, ka, kb1, kb2, qr, cinit); }
}
template <int NQ>
__device__ __forceinline__ void qkt(f32x16& p0, f32x16& p1, const char* Ks, const int (&kq1)[2], const int (&kq2)[2], const bf16x8* qr, const f32x16& cinit) {
    int kb1[8], kb2[4];
#pragma unroll
    for (int i = 0; i < 8; ++i) kb1[i] = kq1[0] + ((i ^ kq1[1]) << 5);
#pragma unroll
    for (int i = 0; i < 4; ++i) kb2[i] = kq2[0] + ((i ^ kq2[1]) << 5);
    constexpr bool HAS1 = NQ >= 8, HAS2 = NQ != 8; constexpr int SHM_K1 = HAS1 ? 16384 : 0;
    p0 = cinit; p1 = cinit;
    if (HAS1) {
#pragma unroll
        for (int d0 = 0; d0 < 8; ++d0) { const char* a = Ks + kb1[d0];
            const bf16x8 b0 = *reinterpret_cast<const bf16x8*>(a); const bf16x8 b1 = *reinterpret_cast<const bf16x8*>(a + 8192);
            p0 = __builtin_amdgcn_mfma_f32_32x32x16_bf16(b0, qr[d0], p0, 0, 0, 0);
            p1 = __builtin_amdgcn_mfma_f32_32x32x16_bf16(b1, qr[d0], p1, 0, 0, 0); } }
    if (HAS2) {
#pragma unroll
        for (int d = 0; d < 4; ++d) { const char* a = Ks + SHM_K1 + kb2[d];
            const bf16x8 b0 = *reinterpret_cast<const bf16x8*>(a); const bf16x8 b1 = *reinterpret_cast<const bf16x8*>(a + 4096);
            p0 = __builtin_amdgcn_mfma_f32_32x32x16_bf16(b0, qr[(NQ == 12 ? 8 : 0) + d], p0, 0, 0, 0);
            p1 = __builtin_amdgcn_mfma_f32_32x32x16_bf16(b1, qr[(NQ == 12 ? 8 : 0) + d], p1, 0, 0, 0); } }
}
template <int NQ, int MODE>
__device__ __forceinline__ void attn_core(const bf16_t* __restrict__ Qb, int ldq, const bf16_t* __restrict__ K0, int ldk0, const bf16_t* __restrict__ K1, int ldk1,
                                          const bf16_t* __restrict__ Vh, int ldv, int kt0, int NT, int q0, const float* lut, float cbL, float cbR, float m_init, float l_init,
                                          char* lds, f32x16 (&o)[4], int wave_s) {
    constexpr bool HAS1 = NQ >= 8, HAS2 = NQ != 8;
    constexpr int SHM_K1 = HAS1 ? 16384 : 0, SHM_K2 = HAS2 ? 8192 : 0, SHM_KT = SHM_K1 + SHM_K2;
    constexpr int NLK = (HAS1 ? 2 : 0) + (HAS2 ? 1 : 0), NLV = 2, NL = NLK + NLV;
    constexpr bool FOLD = (NQ != 12 && MODE != 2);
    int tid_ = tid_of(wave_s);
    const int tid = tid_, wid = wave_s, lane = tid & 63, r32 = lane & 31, hi = lane >> 5;
    char* K_lds = lds + OFF_K; char* V_lds = lds + OFF_V;
    float* ws = (float*)(lds + OFF_WS) + wid * 64; float* li_l = ws; float* al_l = ws + 32;
    constexpr bool RSM = (NQ == 4);
    float m_reg = m_init, l_reg = l_init;
    f32x16 lacc;
#pragma unroll
    for (int r = 0; r < 16; ++r) lacc[r] = l_init;
#pragma unroll
    for (int d = 0; d < 4; ++d) o[d] = f32x16{};
    const int ldk2 = (NQ == 4) ? ldk0 : ldk1; const bf16_t* K2 = (NQ == 4) ? K0 : K1;
    unsigned voK1[2], voK2, voV[2];
#pragma unroll
    for (int i = 0; i < 2; ++i) { const int p = wid + 8 * i, row = 4 * p + (lane >> 4), cbs = (lane & 15) ^ (row & 15); voK1[i] = (unsigned)(row * ldk0 + cbs * 8) * 2u; }
    { const int row = 8 * wid + (lane >> 3), cbs = (lane & 7) ^ ((row >> 1) & 7); voK2 = (unsigned)(row * ldk2 + cbs * 8) * 2u; }
#pragma unroll
    for (int i = 0; i < 2; ++i) { const int p = wid + 8 * i, sub = 2 * p + (lane >> 5), kk = ((sub >> 2) << 3) | ((lane & 31) >> 2);
        const int k = kk, c = (sub & 3) * 32 + (lane & 3) * 8; voV[i] = (unsigned)(k * ldv + c) * 2u; }
    const char* gK1 = (const char*)(K0 + (size_t)kt0 * KVBLK * ldk0); const size_t stK1 = (size_t)KVBLK * ldk0 * 2;
    const char* gK2 = (const char*)(K2 + (size_t)kt0 * KVBLK * ldk2); const size_t stK2 = (size_t)KVBLK * ldk2 * 2;
    const char* gV = (const char*)(Vh + (size_t)kt0 * KVBLK * ldv); const size_t stV = (size_t)KVBLK * ldv * 2;
    LAS unsigned char* K3 = (LAS unsigned char*)K_lds; LAS unsigned char* V3 = (LAS unsigned char*)V_lds;
#define GLDS(g, l) __builtin_amdgcn_global_load_lds((const unsigned*)(g), (LAS unsigned*)(l), 16, 0, 0)
#define DMA_K(t, st) do { if (HAS1) { GLDS(gK1 + (size_t)(t) * stK1 + voK1[0], K3 + (st) * SHM_KT + wid * 1024); GLDS(gK1 + (size_t)(t) * stK1 + voK1[1], K3 + (st) * SHM_KT + (wid + 8) * 1024); } \
    if (HAS2) GLDS(gK2 + (size_t)(t) * stK2 + voK2, K3 + (st) * SHM_KT + SHM_K1 + wid * 1024); } while (0)
#define DMA_V(t, st) do { GLDS(gV + (size_t)(t) * stV + voV[0], V3 + (st) * SHM_V + wid * 1024); GLDS(gV + (size_t)(t) * stV + voV[1], V3 + (st) * SHM_V + (wid + 8) * 1024); } while (0)
#define WAIT_BAR(N) asm volatile("s_waitcnt vmcnt(" #N ") lgkmcnt(0)\n\ts_barrier" ::: "memory")
#define WAITB(n) do { if ((n) == 0) WAIT_BAR(0); else if ((n) == 1) WAIT_BAR(1); else if ((n) == 2) WAIT_BAR(2); else if ((n) == 3) WAIT_BAR(3); else if ((n) == 4) WAIT_BAR(4); else WAIT_BAR(5); } while (0)
    bf16x8 qr[NQ];
    const bf16_t* Qw = Qb + (long)(wid * QBLK + r32) * ldq + hi * 8;
    __syncthreads();
#pragma unroll
    for (int d0 = 0; d0 < NQ; ++d0) qr[d0] = *reinterpret_cast<const bf16x8*>(Qw + d0 * 16);
    DMA_K(0, 0); DMA_V(0, 0); DMA_K(1, 1);
    const int lo1 = (hi ^ (r32 & 1)) << 4, s3 = (r32 >> 1) & 7, b1_ = r32 * 256 + lo1;
    const int kb1[2] = {b1_, s3};
    const int lo2 = (hi ^ ((r32 >> 1) & 1)) << 4, s2 = (r32 >> 2) & 3, b2_ = r32 * 128 + lo2;
    const int kb2[2] = {b2_, s2};
    const int vb0 = (int)(uintptr_t)V_lds + v_rd_base(lane);
    const int kl0 = (int)(uintptr_t)K_lds;
    const int qw = q0 + wid * QBLK;
#define RESC(a, rs) do { if (rs) { if (hi == 0) al_l[r32] = (a); asm volatile("s_waitcnt lgkmcnt(0)" ::: "memory"); \
    _Pragma("unroll") for (int r = 0; r < 16; ++r) { const float al_ = al_l[crow(r, hi)]; if (RSM) lacc[r] *= al_; _Pragma("unroll") for (int d = 0; d < 4; ++d) o[d][r] *= al_; } } l_reg *= (a); } while (0)
#define TILEP(t) const int k0t = (kt0 + (t)) * KVBLK; const int relb = k0t - qw - r32 + 4 * hi; \
    const bool nearT = (MODE == 2) ? true : ((MODE == 1) ? !(k0t + 154 <= qw || k0t >= qw + 122) : false); \
    const float cbT = (MODE == 1 && !nearT) ? (k0t < qw ? cbL : cbR) : 0.f;
    f32x16 cinit = f32x16{}; float cur_cb = 0.f; bool dirty = true;
#define CINIT(t) do { TILEP(t); (void)relb; if (FOLD && (dirty || cbT != cur_cb)) { const float v_ = cbT - m_reg; _Pragma("unroll") for (int r = 0; r < 16; ++r) cinit[r] = v_; asm volatile("" : "+v"(cinit)); cur_cb = cbT; dirty = false; } } while (0)
    f32x16 pA0, pA1, pB0, pB1; float alA, alB; bool rsA, rsB; bf16x8 pa0, pa1, pa2, pa3;
    WAITB(NLK);
    if (2 < NT) DMA_K(2, 2); DMA_V(1, 1);
    CINIT(0);
    qkt<NQ>(pA0, pA1, K_lds, kb1, kb2, qr, cinit); { TILEP(0); (void)cbT; rsA = partialSM<MODE, true, FOLD>(pA0, pA1, m_reg, alA, relb, nearT, lut, cbT); dirty |= rsA; }
    l_reg *= alA;
    if (2 < NT) WAITB(NL); else WAITB(NLV);
#define grp1 (wid >= 4)
    int kc = 1, vp = 0;
#define KST(x) ((x) >= 3 ? (x) - 3 : (x))
#define VST(x) ((x) >= 4 ? (x) - 4 : (x))
    bf16x8 kfp0 = {}, kfp1 = {};
#define KPRE(st) do { if (NQ == 12) break; const char* kp_ = K_lds + (st) * SHM_KT; if (HAS1) { const int a_ = kb1[0] + (kb1[1] << 5); kfp0 = *reinterpret_cast<const bf16x8*>(kp_ + a_); kfp1 = *reinterpret_cast<const bf16x8*>(kp_ + a_ + 8192); } \
    else { const int a_ = kb2[0] + (kb2[1] << 5); kfp0 = *reinterpret_cast<const bf16x8*>(kp_ + a_); kfp1 = *reinterpret_cast<const bf16x8*>(kp_ + a_ + 4096); } SBAR(); } while (0)
#define EVENT(jj) do { if (__builtin_expect((jj) + 3 < NT, 1)) { WAITB(NL); DMA_K((jj) + 3, kc); DMA_V((jj) + 2, VST(vp + 3)); }     \
    else if ((jj) + 3 == NT) { WAITB(NL); DMA_V((jj) + 2, VST(vp + 3)); } else { WAITB(NLV); } } while (0)
#define STEP(C0, C1, P0, P1, alC, rsC, jj) do { \
    SBAR(); qk_fsm<NQ>(C0, C1, P0, P1, l_reg, pa0, pa1, pa2, pa3, kl0 + kc * SHM_KT, kb1, kb2, qr, cinit, kfp0, kfp1); SBAR(); \
    if (grp1) EVENT(jj); \
    pv_d0<RSM>(o, lacc, vb0 + vp * SHM_V, pa0, pa1, pa2, pa3); \
    if (!grp1) EVENT(jj); \
    kc = KST(kc + 1); vp = VST(vp + 1); \
    KPRE(kc); \
    { TILEP(jj); (void)cbT; rsC = partialSM<MODE, false, FOLD>(C0, C1, m_reg, alC, relb, nearT, lut, cbT); dirty |= rsC; } \
    RESC(alC, rsC); CINIT((jj) + 1); } while (0)
    DMA_K(3, 0); DMA_V(2, 2);
    KPRE(kc); CINIT(1);
    for (int j = 1; j + 1 < NT; j += 2) {
        STEP(pB0, pB1, pA0, pA1, alB, rsB, j);
        STEP(pA0, pA1, pB0, pB1, alA, rsA, j + 1);
    }
    SBAR(); qk_fsm<NQ>(pB0, pB1, pA0, pA1, l_reg, pa0, pa1, pa2, pa3, kl0 + kc * SHM_KT, kb1, kb2, qr, cinit, kfp0, kfp1); SBAR();
    if (grp1) WAITB(0);
    pv_d0<RSM>(o, lacc, vb0 + vp * SHM_V, pa0, pa1, pa2, pa3);
    if (!grp1) WAITB(0);
    { TILEP(NT - 1); (void)cbT; rsB = partialSM<MODE, false, FOLD>(pB0, pB1, m_reg, alB, relb, nearT, lut, cbT); }
    RESC(alB, rsB);
    finishSM<RSM>(pB0, pB1, l_reg, pa0, pa1, pa2, pa3); SBAR();
    pv_d0<RSM>(o, lacc, vb0 + VST(vp + 1) * SHM_V, pa0, pa1, pa2, pa3);
    (void)alA;
    if (hi == 0) li_l[r32] = l_reg; asm volatile("s_waitcnt lgkmcnt(0)" ::: "memory");
#pragma unroll
    for (int r = 0; r < 16; ++r) { const float rl = __builtin_amdgcn_rcpf(RSM ? lacc[r] : li_l[crow(r, hi)]);
#pragma unroll
        for (int d = 0; d < 4; ++d) o[d][r] *= rl; }
#undef GLDS
#undef DMA_K
#undef DMA_V
#undef WAIT_BAR
#undef WAITB
#undef RESC
#undef TILEP
#undef CINIT
#undef KPRE
#undef EVENT
#undef STEP
#undef grp1
#undef KST
#undef VST
}
#undef SBAR
}


#define XB_TMO      128
#define XB_XCNT(j)  (256  + 64 * (j))
#define XB_XSUB(j)  (1280 + 64 * (j))
#define XB_XGEN(j)  (2304 + 64 * (j))
#define XB_TOP      3328
#define XB_TOPGEN   3392
#define XCD_BAR_WORDS 3456
#define XB_SPIN_CAP (1u << 22)
__device__ __forceinline__ unsigned xb_ld(unsigned* p)              { return __hip_atomic_load(p, __ATOMIC_RELAXED, __HIP_MEMORY_SCOPE_AGENT); }
__device__ __forceinline__ unsigned xb_add(unsigned* p, unsigned v) { return __hip_atomic_fetch_add(p, v, __ATOMIC_RELAXED, __HIP_MEMORY_SCOPE_AGENT); }
__device__ __forceinline__ unsigned xb_xcc_id() { return (unsigned)__builtin_amdgcn_s_getreg((3 << 11) | 20) & 0xFu; }
#define XB_SPIN(cond, bar) do { unsigned _sp = 0; while (cond) { __builtin_amdgcn_s_sleep(1); \
    if ((++_sp & 255u) == 0u) { if (xb_ld(&(bar)[XB_TMO])) break; if (_sp > XB_SPIN_CAP) { atomicAdd(&(bar)[XB_TMO], 1u); break; } } } } while (0)
struct XcdBarrier { unsigned* bar; unsigned x; volatile LAS unsigned* st; };
__device__ __forceinline__ XcdBarrier xcd_barrier_post(unsigned* bar, volatile LAS unsigned* st, bool tid0) {
    XcdBarrier b; b.bar = bar; b.x = xb_xcc_id(); b.st = st;
    if (tid0) (void)xb_add(&bar[XB_XCNT(b.x)], 1u);
    return b;
}
__device__ __forceinline__ void xcd_barrier_complete(unsigned* bar, unsigned x, unsigned& nloc, unsigned& nx) {
    const unsigned G = gridDim.x * gridDim.y * gridDim.z;
    unsigned sum, cnt, mine, sp = 0u;
    for (;;) {
        sum = 0u; cnt = 0u; mine = 0u;
#pragma unroll
        for (unsigned j = 0; j < 16; ++j) { const unsigned c = xb_ld(&bar[XB_XCNT(j)]); sum += c; cnt += (c > 0u) ? 1u : 0u; mine = (j == x) ? c : mine; }
        if (sum == G) break;
        __builtin_amdgcn_s_sleep(1);
        if ((++sp & 255u) == 0u) { if (xb_ld(&bar[XB_TMO])) break; if (sp > XB_SPIN_CAP) { atomicAdd(&bar[XB_TMO], 1u); break; } }
    }
    nloc = mine > 0u ? mine : 1u; nx = cnt > 0u ? cnt : 1u;
}
__device__ __forceinline__ void xcd_barrier(const XcdBarrier& b, int wave_s) {
    asm volatile("s_waitcnt vmcnt(0)" ::: "memory");
    __syncthreads();
    if (tid_of(wave_s) == 0) {
        unsigned* bar = b.bar;
        __builtin_amdgcn_s_waitcnt(0);
        unsigned nloc = b.st[0], nx = b.st[1];
        if (nloc == 0u) { xcd_barrier_complete(bar, b.x, nloc, nx); b.st[0] = nloc; b.st[1] = nx; }
        const unsigned old = xb_add(&bar[XB_XSUB(b.x)], 1u);
        const unsigned gen = old / nloc;
        if (old + 1u == (gen + 1u) * nloc) {
            __builtin_amdgcn_fence(__ATOMIC_RELEASE, "agent");
            asm volatile("s_waitcnt vmcnt(0)" ::: "memory");
            const unsigned og = xb_add(&bar[XB_TOP], 1u);
            const unsigned tg = og / nx;
            if (og + 1u == (tg + 1u) * nx) xb_add(&bar[XB_TOPGEN], 1u);
            else XB_SPIN(xb_ld(&bar[XB_TOPGEN]) == tg, bar);
            __builtin_amdgcn_fence(__ATOMIC_ACQUIRE, "agent");
            xb_add(&bar[XB_XGEN(b.x)], 1u);
            asm volatile("s_waitcnt vmcnt(0)" ::: "memory");
        } else {
            XB_SPIN(xb_ld(&bar[XB_XGEN(b.x)]) == gen, bar);
            __builtin_amdgcn_fence(__ATOMIC_ACQUIRE, "agent");
            asm volatile("s_waitcnt vmcnt(0)" ::: "memory");
        }
    }
    __syncthreads();
}

constexpr int NWAVES = 8, NTHR = 512;
constexpr int LDS_BYTES = 147456;
constexpr int MISC_OFF = 146432;
static_assert(att::ATT_LDS <= MISC_OFF && pg8::STAGE_BYTES <= MISC_OFF && MISC_OFF + 16 <= LDS_BYTES, "LDS map");

struct Args {
    const float* x; const float* c; const float* w_ada; const float* b_ada; const float* norm1; const float* w_in; const float* a_q_norm; const float* a_k_norm;
    const float* b_q_norm; const float* b_kv_norm; const float* b_w_uq; const float* b_w_ukv; const float* c_sink; const float* d_lambda; const float* d_sub_norm;
    const float* w_out; const float* norm2; const float* w_ff1; const float* w_ff2; const float* rel_bias; const float* final_norm;
    float* out; unsigned char* ws;
};

__device__ __forceinline__ int perm128(int p) { const int half = p >> 6, w = p & 63; return half * 64 + (w >> 1) + 32 * (w & 1); }
__device__ __forceinline__ int perm64(int p) { return (p >> 1) + 32 * (p & 1); }
template <int MAP> __device__ __forceinline__ int srcmap(int nd, float& sc) {
    sc = 1.f;
    if (MAP == 0) return nd;
    if (MAP == 1) {
        if (nd >= INC) return -1;
        if (nd < C_AV) return (nd & ~127) + perm128(nd & 127);
        if (nd >= C_BKR && nd < C_CQ) return C_BKR + perm64(nd - C_BKR);
        if (nd >= C_CQ && nd < C_CK) sc = SC_A;
        if (nd >= C_DQ && nd < C_DK) sc = SC_D;
        return nd;
    }
    sc = SC_B; const int hd = nd / 192, p = nd % 192;
    return p < 128 ? nd : hd * 192 + 128 + perm64(p - 128);
}
template <int MAP>
__device__ __forceinline__ void transpose_item(const float* W, int K, int N, int Npad, bf16_t* WT, const float* gk, LAS float* scr, int item, int lane) {
    const int nblk = Npad / 32, kb = item / nblk, nb = item % nblk, k0 = 64 * kb, n0 = 32 * nb;
    float sc; const int ns = srcmap<MAP>(n0 + (lane & 31), sc);
    float wv[32];
    const float* Wp = W + (size_t)(k0 + (lane >> 5)) * N + (ns >= 0 ? ns : 0);
#pragma unroll
    for (int i = 0; i < 32; ++i) wv[i] = Wp[(size_t)(2 * i) * N];
#pragma unroll
    for (int i = 0; i < 32; ++i) { const int kk = 2 * i + (lane >> 5); float v = ns >= 0 ? wv[i] : 0.f; if (gk) v *= gk[k0 + kk]; scr[kk * 33 + (lane & 31)] = v * sc; }
    asm volatile("s_waitcnt lgkmcnt(0)" ::: "memory");
    const int c = lane & 7;
#pragma unroll
    for (int j = 0; j < 4; ++j) { const int n = (lane >> 3) + 8 * j; const LAS float* s = scr + (8 * c) * 33 + n;
        u32x4 o; o.x = pk2(s[0 * 33], s[1 * 33]); o.y = pk2(s[2 * 33], s[3 * 33]); o.z = pk2(s[4 * 33], s[5 * 33]); o.w = pk2(s[6 * 33], s[7 * 33]);
        *(u32x4*)(WT + (size_t)(n0 + n) * K + k0 + 8 * c) = o; }
    asm volatile("s_waitcnt lgkmcnt(0)" ::: "memory");
}
__device__ __forceinline__ int t5_bucket(int rel) {
    const int n = rel < 0 ? -rel : rel;
    int b = n < 8 ? n : min(15, 2 + (31 - __clz(n * n)));
    return b + (rel > 0 ? 16 : 0);
}

template <bool FINAL>
__device__ __forceinline__ void norm_pass(const float* X, const float* g, const float* scale, const float* shift, bf16_t* H, float* OUTF, int vcu_, int NGW_, int wave_s) {
    int vcu = vcu_, NGW = NGW_; asm volatile("" : "+s"(vcu), "+s"(NGW));
    int tid_ = tid_of(wave_s);
    const int lane = tid_ & 63, gw = vcu * NWAVES + wave_s;
    f32x4 gm[8], sh[8];
#pragma unroll
    for (int j = 0; j < 8; ++j) { const f32x4 gv = ((const f32x4*)g)[64 * j + lane];
        if (!FINAL) { const f32x4 s = ((const f32x4*)scale)[64 * j + lane]; gm[j] = gv * (1.f + s); sh[j] = ((const f32x4*)shift)[64 * j + lane]; } else { gm[j] = gv; sh[j] = (f32x4){0.f, 0.f, 0.f, 0.f}; } }
    f32x4 nv[8];
    { const f32x4* xr = (const f32x4*)(X + (size_t)gw * DM) + lane;
#pragma unroll
        for (int j = 0; j < 8; ++j) nv[j] = xr[64 * j]; }
    for (int m = gw; m < SEQ; m += NGW) {
        f32x4 v[8]; float ss = 0.f;
#pragma unroll
        for (int j = 0; j < 8; ++j) v[j] = nv[j];
        if (m + NGW < SEQ) { const f32x4* xn = (const f32x4*)(X + (size_t)(m + NGW) * DM) + lane;
#pragma unroll
            for (int j = 0; j < 8; ++j) nv[j] = xn[64 * j]; }
#pragma unroll
        for (int j = 0; j < 8; ++j) ss += (v[j].x * v[j].x + v[j].y * v[j].y) + (v[j].z * v[j].z + v[j].w * v[j].w);
        const float rstd = 1.0f / sqrtf(wave_sum(ss) * (1.f / DM) + EPS);
        if (FINAL) { f32x4* orow = (f32x4*)(OUTF + (size_t)m * DM) + lane;
#pragma unroll
            for (int j = 0; j < 8; ++j) orow[64 * j] = v[j] * rstd * gm[j]; }
        else { u32x2* orow = (u32x2*)(H + (size_t)m * DM) + lane;
#pragma unroll
            for (int j = 0; j < 8; ++j) { const f32x4 y = v[j] * rstd * gm[j] + sh[j]; u32x2 w; w.x = pk2(y.x, y.y); w.y = pk2(y.z, y.w); orow[64 * j] = w; } }
    }
}


__device__ __forceinline__ void store_o_tile(const f32x16 (&o)[4], char* lds, bf16_t* Og, int wave_s) {
    int tid_ = tid_of(wave_s);
    const int wid = tid_ >> 6, lane = tid_ & 63, r32 = lane & 31, hi = lane >> 5;
    __syncthreads();
    bf16_t* stg = (bf16_t*)(lds + wid * 8192);
#pragma unroll
    for (int r = 0; r < 16; ++r) { const int orow = att::crow(r, hi);
#pragma unroll
        for (int d0 = 0; d0 < 4; ++d0) stg[orow * 128 + d0 * 32 + r32] = (bf16_t)f2bf(o[d0][r]); }
    asm volatile("s_waitcnt lgkmcnt(0)" ::: "memory");
#pragma unroll
    for (int i = 0; i < 8; ++i) { const int row = i * 4 + (lane >> 4), ch = lane & 15; const u32x4 v = *(const u32x4*)(stg + row * 128 + ch * 8); *(u32x4*)(Og + (size_t)row * DM + ch * 8) = v;
        if (i & 1) asm volatile("" ::: "memory"); }
    asm volatile("s_waitcnt lgkmcnt(0)" ::: "memory");
}

__global__ void __launch_bounds__(NTHR, 2) mega_fwd(Args a) {
    extern __shared__ __attribute__((aligned(16))) unsigned char lds[];
    cg::grid_group grid = cg::this_grid();
    const int wave_s = __builtin_amdgcn_readfirstlane((int)threadIdx.x >> 6);
    const int tid = tid_of(wave_s), lane = tid & 63, wave = wave_s;
    const int G = gridDim.x, bx = blockIdx.x;
    const int vcu = (G % 8 == 0) ? (bx % 8) * (G / 8) + bx / 8 : bx;
    const int gw = vcu * NWAVES + wave, NGW = G * NWAVES;
#define PH unsigned char* ws = a.ws; asm volatile("" : "+s"(ws)); int lq = l; asm volatile("" : "+s"(lq)); (void)lq;
#define LAM ((float*)(ws + WS_CTL))
#define SMV ((float*)(ws + WS_SMALL))
#define MOD ((float*)(ws + WS_MOD))
#define TAB ((f32x2*)(ws + WS_TAB))
#define RS ((float*)(ws + WS_RS))
#define WIN ((bf16_t*)(ws + WS_WIN))
#define WUQ ((bf16_t*)(ws + WS_WUQ))
#define WUKV ((bf16_t*)(ws + WS_WUKV))
#define WOUT ((bf16_t*)(ws + WS_WOUT))
#define WFF1 ((bf16_t*)(ws + WS_WFF1))
#define WFF2 ((bf16_t*)(ws + WS_WFF2))
#define H ((bf16_t*)(ws + WS_H))
#define DSCR ((float*)(ws + WS_DSCR))
#define P ((bf16_t*)(ws + WS_P))
#define QB ((bf16_t*)(ws + WS_QB))
#define KVB ((bf16_t*)(ws + WS_KVB))
#define O ((bf16_t*)(ws + WS_O))
#define HID ((bf16_t*)(ws + WS_HID))
    LAS unsigned char* ldsl = (LAS unsigned char*)lds;

    {
        const int l = 0; PH
        LAS float* scr = (LAS float*)(ldsl + wave * 16384);
        constexpr int I_IN = (DM / 64) * (INP / 32), I_UQ = (384 / 64) * (768 / 32), I_UKV = (256 / 64) * (1024 / 32), I_OUT = (DM / 64) * (DM / 32), I_F1 = (DM / 64) * (DFF / 32), I_F2 = (DFF / 64) * (DM / 32);
        constexpr int I_L = I_IN + I_UQ + I_UKV + I_OUT + I_F1 + I_F2;
        for (int it = gw; it < NLAYER * I_L; it += NGW) {
            const int l = it / I_L; int r = it % I_L;
            if (r < I_IN) { transpose_item<1>(a.w_in + (size_t)l * DM * INC, DM, INC, INP, WIN + (size_t)l * INP * DM, nullptr, scr, r, lane); continue; } r -= I_IN;
            if (r < I_UQ) { transpose_item<2>(a.b_w_uq + (size_t)l * 384 * 768, 384, 768, 768, WUQ + (size_t)l * 768 * 384, a.b_q_norm + l * 384, scr, r, lane); continue; } r -= I_UQ;
            if (r < I_UKV) { transpose_item<0>(a.b_w_ukv + (size_t)l * 256 * 1024, 256, 1024, 1024, WUKV + (size_t)l * 1024 * 256, a.b_kv_norm + l * 256, scr, r, lane); continue; } r -= I_UKV;
            if (r < I_OUT) { transpose_item<0>(a.w_out + (size_t)l * DM * DM, DM, DM, DM, WOUT + (size_t)l * DM * DM, nullptr, scr, r, lane); continue; } r -= I_OUT;
            if (r < I_F1) { transpose_item<0>(a.w_ff1 + (size_t)l * DM * DFF, DM, DFF, DFF, WFF1 + (size_t)l * DFF * DM, nullptr, scr, r, lane); continue; } r -= I_F1;
            transpose_item<0>(a.w_ff2 + (size_t)l * DFF * DM, DFF, DM, DM, WFF2 + (size_t)l * DM * DFF, nullptr, scr, r, lane);
        }
        for (int e = bx * NTHR + tid; e < SEQ * 32; e += G * NTHR) {
            const int pos = e >> 5, i = e & 31;
            const float inv = (float)exp2(-(double)i * (13.287712379549449 / 32.0));
            const float ang = (float)pos * inv;
            const double rev = (double)ang * 0.15915494309189535; const float fr = (float)(rev - rint(rev));
            TAB[e] = (f32x2){__builtin_amdgcn_cosf(fr), __builtin_amdgcn_sinf(fr)};
        }
        if (bx == 0) { float* sm = SMV;
            for (int i = tid; i < 4096; i += NTHR) { sm[SM_N1 + i] = a.norm1[i]; sm[SM_N2 + i] = a.norm2[i]; }
            for (int i = tid; i < 2048; i += NTHR) sm[SM_FN + i] = a.final_norm[i];
            if (tid < 256) { sm[SM_AQ + tid] = a.a_q_norm[tid]; sm[SM_AK + tid] = a.a_k_norm[tid]; sm[SM_DS + tid] = a.d_sub_norm[tid]; sm[SM_RB + tid] = a.rel_bias[tid]; }
            if (tid < 8) sm[SM_CS + tid] = a.c_sink[tid]; }
        if (bx == 0) for (int i = tid; i < XCD_BAR_WORDS; i += NTHR) ((unsigned*)(ws + WS_BAR))[i] = 0u;
        if (tid < 4) ((LAS unsigned*)(ldsl + MISC_OFF))[tid] = 0u;
        if (bx == 0 && wave == 0) {
            for (int l = 0; l < NLAYER; ++l) { const float* lf = a.d_lambda + l * 256;
                const float sa = wave_sum(lf[lane] * lf[64 + lane]), sb = wave_sum(lf[128 + lane] * lf[192 + lane]);
                const float lam_init = 0.8f - 0.6f * expf(-0.3f * (float)l);
                if (lane == 0) LAM[l] = expf(sa) - expf(sb) + lam_init; }
        }
        __syncthreads();
        LAS float* red = (LAS float*)ldsl;
        for (int ch = bx; ch < NLAYER * 192; ch += G) {
            const int l = ch / 192, n0 = (ch % 192) * 64; const float* W = a.w_ada + (size_t)l * DM * 12288;
            const int cg4 = lane & 15, ksub = lane >> 4; f32x4 acc = {0.f, 0.f, 0.f, 0.f};
#pragma unroll 16
            for (int kk = 0; kk < 64; ++kk) { const int k = wave * 256 + kk * 4 + ksub; const float cv = a.c[k]; const float sv = cv / (1.f + expf(-cv));
                const f32x4 w = *(const f32x4*)(W + (size_t)k * 12288 + n0 + cg4 * 4); acc += w * sv; }
#pragma unroll
            for (int e = 0; e < 4; ++e) { acc[e] += swz_xor<16>(acc[e]); auto rr = __builtin_amdgcn_permlane32_swap(__float_as_uint(acc[e]), __float_as_uint(acc[e]), false, false); acc[e] = __uint_as_float(rr[0]) + __uint_as_float(rr[1]); }
            if (ksub == 0) { red[wave * 64 + cg4 * 4 + 0] = acc[0]; red[wave * 64 + cg4 * 4 + 1] = acc[1]; red[wave * 64 + cg4 * 4 + 2] = acc[2]; red[wave * 64 + cg4 * 4 + 3] = acc[3]; }
            __syncthreads();
            if (tid < 64) { float s = 0.f;
#pragma unroll
                for (int w = 0; w < 8; ++w) s += red[w * 64 + tid];
                MOD[l * 12288 + n0 + tid] = s + a.b_ada[l * 12288 + n0 + tid]; }
            __syncthreads();
        }
    }
    grid.sync();
    (void)xcd_barrier_post((unsigned*)(a.ws + WS_BAR), (volatile LAS unsigned*)(ldsl + MISC_OFF), tid_of(wave_s) == 0);
#define GRID_BAR() do { unsigned char* wsb = a.ws; asm volatile("" : "+s"(wsb)); XcdBarrier xb_; xb_.bar = (unsigned*)(wsb + WS_BAR); xb_.x = xb_xcc_id(); xb_.st = (volatile LAS unsigned*)(ldsl + MISC_OFF); xcd_barrier(xb_, wave_s); } while (0)

    for (int l = 0; l < NLAYER; ++l) {
        const int tid = tid_of(wave_s), lane = tid & 63, wave = wave_s, gw = vcu * NWAVES + wave;
        { PH const float* mod = MOD + lq * 12288; norm_pass<false>((lq == 0) ? a.x : a.out, SMV + SM_N1 + lq * DM, mod + 1 * DM, mod + 0 * DM, H, nullptr, vcu, NGW, wave_s); }
        GRID_BAR();
        { PH pg8::Gemm g{H, WIN + (size_t)lq * INP * DM, SEQ, INP, DM, DM}; pg8::StaticOrder S; S.init(SEQ, INP, G, bx);
          pg8::EpiBf16<0> E{P, INP, nullptr, nullptr}; pg8::gemm_phase(ldsl, g, S, E, wave_s); }
        GRID_BAR();
        { PH
            const float* gq = SMV + SM_AQ + lq * 128; const float* gk = SMV + SM_AK + lq * 128;
            const int p0i = perm128(2 * lane), p1i = perm128(2 * lane + 1);
            const float gq0 = gq[p0i], gq1 = gq[p1i], gk0 = gk[p0i], gk1 = gk[p1i];
            for (int t = gw; t < SEQ; t += NGW) {
                bf16_t* row = P + (size_t)t * INP;
                unsigned w[12];
#pragma unroll
                for (int hd = 0; hd < 6; ++hd) w[hd] = ((const unsigned*)(row + hd * 128))[lane];
                w[6] = ((const unsigned*)(row + C_BKR))[lane & 31];
#pragma unroll
                for (int j = 0; j < 3; ++j) w[7 + j] = ((const unsigned*)(row + C_BCQ))[lane + 64 * j];
#pragma unroll
                for (int j = 0; j < 2; ++j) w[10 + j] = ((const unsigned*)(row + C_BCKV))[lane + 64 * j];
                const int pos = lane < 32 ? (t >> 6) : (t & 63); const f32x2 cs = TAB[pos * 32 + (lane & 31)], c2 = TAB[t * 32 + (lane & 31)];
#pragma unroll
                for (int hd = 0; hd < 6; ++hd) {
                    float x0 = bf2f((unsigned short)(w[hd] & 0xffff)), x1 = bf2f((unsigned short)(w[hd] >> 16));
                    const float rstd = 1.0f / sqrtf(wave_sum(x0 * x0 + x1 * x1) * (1.f / 128.f) + EPS);
                    const float qs = hd < 4 ? SC_A : 1.f;
                    x0 *= rstd * (hd < 4 ? gq0 : gk0) * qs; x1 *= rstd * (hd < 4 ? gq1 : gk1) * qs;
                    ((unsigned*)(row + hd * 128))[lane] = pk2(x0 * cs.x - x1 * cs.y, x1 * cs.x + x0 * cs.y); }
                if (lane < 32) { const float x0 = bf2f((unsigned short)(w[6] & 0xffff)), x1 = bf2f((unsigned short)(w[6] >> 16));
                    ((unsigned*)(row + C_BKR))[lane] = pk2(x0 * c2.x - x1 * c2.y, x1 * c2.x + x0 * c2.y); }
                float sq = 0.f, skv = 0.f;
#pragma unroll
                for (int j = 0; j < 3; ++j) { const float x0 = bf2f((unsigned short)(w[7 + j] & 0xffff)), x1 = bf2f((unsigned short)(w[7 + j] >> 16)); sq += x0 * x0 + x1 * x1; }
#pragma unroll
                for (int j = 0; j < 2; ++j) { const float x0 = bf2f((unsigned short)(w[10 + j] & 0xffff)), x1 = bf2f((unsigned short)(w[10 + j] >> 16)); skv += x0 * x0 + x1 * x1; }
                sq = wave_sum(sq); skv = wave_sum(skv);
                if (lane == 0) { RS[t] = 1.0f / sqrtf(sq * (1.f / 384.f) + EPS); RS[SEQ + t] = 1.0f / sqrtf(skv * (1.f / 256.f) + EPS); }
            }
        }
        GRID_BAR();
        { PH pg8::Gemm g{P + C_BCQ, WUQ + (size_t)lq * 768 * 384, SEQ, 768, 384, INP}; pg8::StaticOrder S; S.init(SEQ, 768, G, bx);
          pg8::EpiBf16<3> E{QB, 768, RS, TAB}; pg8::gemm_phase(ldsl, g, S, E, wave_s); }
        { PH pg8::Gemm g{P + C_BCKV, WUKV + (size_t)lq * 1024 * 256, SEQ, 1024, 256, INP}; pg8::StaticOrder S; S.init(SEQ, 1024, G, bx);
          pg8::EpiBf16<2> E{KVB, 1024, RS + SEQ, nullptr}; pg8::gemm_phase(ldsl, g, S, E, wave_s); }
        GRID_BAR();
        for (int u = vcu; u < 256; u += G) { PH
            const int hd = u >> 6, blk = u & 63, q0 = blk * 256;
            f32x16 o[4];
#define UNIT_IDS int tidu = tid_of(wave_s); const int wid = tidu >> 6, lane = tidu & 63, r32 = lane & 31, tid = tidu; (void)r32; (void)tid;
            float* lut = (float*)(lds + att::OFF_LUT);
            { UNIT_IDS att::attn_core<8, 0>(P + (size_t)q0 * INP + C_AQ + hd * 128, INP, P + C_AK + (hd >> 1) * 128, INP, nullptr, 0, P + C_AV + (hd >> 1) * 128, INP, 0, SEQ / 64, q0, nullptr, 0.f, 0.f, 0.f, 0.f, (char*)lds, o, wave_s);
              store_o_tile(o, (char*)lds, O + (size_t)(q0 + wid * 32) * DM + (0 + hd) * 128, wave_s); }
            { UNIT_IDS att::attn_core<12, 0>(QB + (size_t)q0 * 768 + hd * 192, 768, KVB + hd * 256, 1024, P + C_BKR, INP, KVB + hd * 256 + 128, 1024, 0, SEQ / 64, q0, nullptr, 0.f, 0.f, 0.f, 0.f, (char*)lds, o, wave_s);
              store_o_tile(o, (char*)lds, O + (size_t)(q0 + wid * 32) * DM + (4 + hd) * 128, wave_s); }
            { UNIT_IDS __syncthreads();
              if (tid < 257) lut[tid] = SMV[SM_RB + t5_bucket(tid - 128) * 8 + hd] * LOG2E;
              const int ks = q0 - 128 < 0 ? 0 : q0 - 128, ke = q0 + 384 > SEQ ? SEQ : q0 + 384;
              const float sink = SMV[SM_CS + lq * 4 + hd] * LOG2E;
              att::attn_core<8, 2>(P + (size_t)q0 * INP + C_CQ + hd * 128, INP, P + C_CK + (hd >> 1) * 128, INP, nullptr, 0, P + C_CV + (hd >> 1) * 128, INP, ks / 64, (ke - ks) / 64, q0, lut, 0.f, 0.f, sink, 1.f, (char*)lds, o, wave_s);
              store_o_tile(o, (char*)lds, O + (size_t)(q0 + wid * 32) * DM + (8 + hd) * 128, wave_s); }
            { UNIT_IDS __syncthreads();
              if (tid < 257) lut[tid] = SMV[SM_RB + t5_bucket(tid - 128) * 8 + 4 + hd] * LOG2E;
              const float cbL = SMV[SM_RB + 15 * 8 + 4 + hd] * LOG2E, cbR = SMV[SM_RB + 31 * 8 + 4 + hd] * LOG2E;
              att::attn_core<4, 1>(P + (size_t)q0 * INP + C_DQ + hd * 128, INP, P + C_DK + hd * 128, INP, nullptr, 0, P + C_DV + hd * 128, INP, 0, SEQ / 64, q0, lut, cbL, cbR, 0.f, 0.f, (char*)lds, o, wave_s);
              { float* scrp = DSCR + ((size_t)(u * 8 + wave_s) * 64) * 64 + (tid_of(wave_s) & 63);
#pragma unroll
              for (int d0 = 0; d0 < 4; ++d0)
#pragma unroll
                  for (int r = 0; r < 16; ++r) scrp[(d0 * 16 + r) * 64] = o[d0][r]; }
              att::attn_core<4, 1>(P + (size_t)q0 * INP + C_DQ + hd * 128 + 64, INP, P + C_DK + hd * 128 + 64, INP, nullptr, 0, P + C_DV + hd * 128, INP, 0, SEQ / 64, q0, lut, cbL, cbR, 0.f, 0.f, (char*)lds, o, wave_s);
              const int lane2 = tid_of(wave_s) & 63, r32b = lane2 & 31;
              const float* scrq = DSCR + ((size_t)(u * 8 + wave_s) * 64) * 64 + lane2; asm volatile("" : "+v"(scrq) :: "memory");
              const float lam = LAM[lq]; const float* gs = SMV + SM_DS + lq * 128; const float post = 1.f - (0.8f - 0.6f * expf(-0.3f * (float)lq));
              float gv[4];
#pragma unroll
              for (int d0 = 0; d0 < 4; ++d0) gv[d0] = gs[d0 * 32 + r32b] * post;
#pragma unroll
              for (int r = 0; r < 16; ++r) { float ss = 0.f;
#pragma unroll
                  for (int d0 = 0; d0 < 4; ++d0) { const float dv = scrq[(d0 * 16 + r) * 64] - lam * o[d0][r]; o[d0][r] = dv; ss += dv * dv; }
                  ss = half_sum(ss);
                  const float rstd = 1.0f / sqrtf(ss * (1.f / 128.f) + EPS);
#pragma unroll
                  for (int d0 = 0; d0 < 4; ++d0) o[d0][r] *= rstd * gv[d0];
                  if ((r & 3) == 3) asm volatile("" ::: "memory"); }
              store_o_tile(o, (char*)lds, O + (size_t)(q0 + wid * 32) * DM + (12 + hd) * 128, wave_s); }
        }
        GRID_BAR();
        { PH pg8::Gemm g{O, WOUT + (size_t)lq * DM * DM, SEQ, DM, DM, DM}; pg8::StaticOrder S; S.init(SEQ, DM, G, bx);
          pg8::EpiRes E{(lq == 0) ? a.x : a.out, a.out, MOD + lq * 12288 + 2 * DM, DM}; pg8::gemm_phase(ldsl, g, S, E, wave_s); }
        GRID_BAR();
        { PH const float* mod = MOD + lq * 12288; norm_pass<false>(a.out, SMV + SM_N2 + lq * DM, mod + 4 * DM, mod + 3 * DM, H, nullptr, vcu, NGW, wave_s); }
        GRID_BAR();
        { PH pg8::Gemm g{H, WFF1 + (size_t)lq * DFF * DM, SEQ, DFF, DM, DM}; pg8::StaticOrder S; S.init(SEQ, DFF, G, bx);
          pg8::EpiBf16<1> E{HID, DFF, nullptr, nullptr}; pg8::gemm_phase(ldsl, g, S, E, wave_s); }
        GRID_BAR();
        { PH pg8::Gemm g{HID, WFF2 + (size_t)lq * DM * DFF, SEQ, DM, DFF, DFF}; pg8::StaticOrder S; S.init(SEQ, DM, G, bx);
          pg8::EpiRes E{a.out, a.out, MOD + lq * 12288 + 5 * DM, DM}; pg8::gemm_phase(ldsl, g, S, E, wave_s); }
        GRID_BAR();
    }
    { const int l = 0; PH norm_pass<true>(a.out, SMV + SM_FN, nullptr, nullptr, nullptr, a.out, vcu, NGW, wave_s); }
}

extern "C" void kernel_launch(void* const* d_in, const int* in_sizes, int n_in, void* d_out, int out_size, void* d_ws, size_t ws_size, hipStream_t stream) {
    static int grid = 0;
    if (grid == 0) {
        if (n_in != 21 || out_size != SEQ * DM || ws_size < WS_END) { fprintf(stderr, "kernel_launch: unexpected shapes (n_in %d out %d ws %zu)\n", n_in, out_size, ws_size); grid = -1; return; }
        int dev = 0, cus = 0, per_cu = 0;
        hipGetDevice(&dev); hipDeviceGetAttribute(&cus, hipDeviceAttributeMultiprocessorCount, dev);
        if (hipFuncSetAttribute((const void*)mega_fwd, hipFuncAttributeMaxDynamicSharedMemorySize, LDS_BYTES) != hipSuccess) { fprintf(stderr, "kernel_launch: hipFuncSetAttribute failed\n"); grid = -1; return; }
        if (hipOccupancyMaxActiveBlocksPerMultiprocessor(&per_cu, (const void*)mega_fwd, NTHR, LDS_BYTES) != hipSuccess || per_cu < 1) { fprintf(stderr, "kernel_launch: occupancy query gave %d\n", per_cu); per_cu = 1; }
        (void)hipGetLastError();
        grid = cus * 1;
    }
    if (grid < 0) return;
    Args a{};
    const float** f = (const float**)&a;
    for (int i = 0; i < 21; ++i) f[i] = (const float*)d_in[i];
    a.out = (float*)d_out; a.ws = (unsigned char*)d_ws;
    void* args[] = {&a};
    hipError_t e = hipLaunchCooperativeKernel((const void*)mega_fwd, dim3(grid), dim3(NTHR), args, LDS_BYTES, stream);
    if (e != hipSuccess) fprintf(stderr, "cooperative launch failed: %s (grid %d)\n", hipGetErrorString(e), grid);
}
```

```cpp
#include <hip/hip_runtime.h>
#include <hip/hip_bf16.h>
#include <hip/hip_cooperative_groups.h>
#include <cstdio>
#include <cstdint>
namespace cg = cooperative_groups;

#define LAS __attribute__((address_space(3)))
typedef unsigned short bf16_t;
typedef short bf16x8 __attribute__((ext_vector_type(8)));
typedef short s16x4 __attribute__((ext_vector_type(4)));
typedef float f32x4 __attribute__((ext_vector_type(4)));
typedef float f32x2 __attribute__((ext_vector_type(2)));
typedef float f32x16 __attribute__((ext_vector_type(16)));
typedef unsigned u32x4 __attribute__((ext_vector_type(4)));
typedef unsigned u32x2 __attribute__((ext_vector_type(2)));

constexpr int SEQ = 16384, DM = 2048, DFF = 8192, INC = 4288, INP = 4352, NLAYER = 2;
constexpr int C_AQ = 0, C_AK = 512, C_AV = 768, C_BCQ = 1024, C_BCKV = 1408, C_BKR = 1664, C_CQ = 1728, C_CK = 2240, C_CV = 2496, C_DQ = 2752, C_DK = 3264, C_DV = 3776;
constexpr float LOG2E = 1.4426950408889634f;
constexpr float SC_A = 0.08838834764831845f * LOG2E;
constexpr float SC_B = 0.07216878364870323f * LOG2E;
constexpr float SC_D = 0.125f * LOG2E;
constexpr float EPS = 1e-6f;

constexpr size_t MiB = 1u << 20;
constexpr size_t WS_CTL = 0;
constexpr size_t WS_SMALL = 131072;
constexpr int SM_N1 = 0, SM_N2 = 4096, SM_FN = 8192, SM_AQ = 10240, SM_AK = 10496, SM_DS = 10752, SM_CS = 11008, SM_RB = 11024, SM_END = 11280;
constexpr size_t WS_BAR = 65536;
constexpr size_t WS_MOD = 1 * MiB;
constexpr size_t WS_TAB = 2 * MiB;
constexpr size_t WS_RS = 6 * MiB;
constexpr size_t WS_WIN = 8 * MiB;
constexpr size_t WS_WUQ = 42 * MiB;
constexpr size_t WS_WUKV = 44 * MiB;
constexpr size_t WS_WOUT = 46 * MiB;
constexpr size_t WS_WFF1 = 62 * MiB;
constexpr size_t WS_WFF2 = 126 * MiB;
constexpr size_t WS_H = 190 * MiB;
constexpr size_t WS_DSCR = 254 * MiB;
constexpr size_t WS_P = 288 * MiB;
constexpr size_t WS_QB = 424 * MiB;
constexpr size_t WS_KVB = 448 * MiB;
constexpr size_t WS_O = 480 * MiB;
constexpr size_t WS_HID = 288 * MiB;
constexpr size_t WS_END = 544 * MiB;

__device__ __forceinline__ int tid_of(int wave_s) { int l; asm volatile("v_mbcnt_lo_u32_b32 %0, -1, 0\n\tv_mbcnt_hi_u32_b32 %0, -1, %0" : "=v"(l)); return wave_s * 64 + l; }
__device__ __forceinline__ unsigned f2bf(float f) { unsigned u = __builtin_bit_cast(unsigned, f); return (u + 0x7fffu + ((u >> 16) & 1u)) >> 16; }
__device__ __forceinline__ unsigned pk2(float lo, float hi) { return f2bf(lo) | (f2bf(hi) << 16); }
__device__ __forceinline__ float bf2f(unsigned short b) { return __builtin_bit_cast(float, (unsigned)b << 16); }
__device__ __forceinline__ unsigned cvtpk(float lo, float hi) { unsigned r; asm volatile("v_cvt_pk_bf16_f32 %0, %1, %2" : "=v"(r) : "v"(lo), "v"(hi)); return r; }
template <int X> __device__ __forceinline__ float swz_xor(float v) { return __builtin_bit_cast(float, __builtin_amdgcn_ds_swizzle(__builtin_bit_cast(int, v), 0x1f | (X << 10))); }
__device__ __forceinline__ float half_sum(float v) {
    v += swz_xor<1>(v); v += swz_xor<2>(v); v += swz_xor<4>(v); v += swz_xor<8>(v); v += swz_xor<16>(v); return v;
}
__device__ __forceinline__ float wave_sum(float v) {
    v = half_sum(v);
    auto rr = __builtin_amdgcn_permlane32_swap(__float_as_uint(v), __float_as_uint(v), false, false);
    return __uint_as_float(rr[0]) + __uint_as_float(rr[1]);
}

namespace pg8 {
constexpr int BM = 256, BK = 64, HALF = 128, HTB = HALF * BK * 2, STAGE_BYTES = 8 * HTB, NXCD = 8, WGM = 8;
__host__ __device__ __forceinline__ int lds_byte(int r, int c) { const int st = (r >> 4) * 2 + (c >> 5), rr = r & 15, cc = c & 31, ob = rr * 64 + cc * 2; return st * 1024 + (ob ^ (((ob >> 9) & 1) << 5)); }
__host__ __device__ __forceinline__ void stage_rc(int b, int& R, int& C) { const int st = b / 1024, sb = b % 1024, swz = sb ^ (((sb >> 9) & 1) << 5); R = (st >> 1) * 16 + swz / 64; C = (st & 1) * 32 + (swz % 64) / 2; }
__host__ __device__ __forceinline__ int perm32(int rho) { const int n = rho >> 4, i = rho & 15; return 8 * (i >> 2) + 4 * n + (i & 3); }
struct Unit { int pm, pn; };
struct Gemm { const bf16_t* A; const bf16_t* Bt; int M, N, K, lda; };
struct StaticOrder {
    int nM, nN, nwg, G, c;
    __host__ __device__ void init(int M, int N, int G_, int c_) { nM = M / BM; nN = N / BM; nwg = nM * nN; G = G_; c = c_; }
    __host__ __device__ bool next(int i, Unit& u) const {
        const long L = (long)i * G + c; if (L >= nwg) return false;
        int wgid = (int)L; { const int q = nwg / NXCD, r = nwg % NXCD, xcd = wgid % NXCD, off = wgid / NXCD; wgid = (xcd < r ? xcd * (q + 1) : r * (q + 1) + (xcd - r) * q) + off; }
        const int nig = WGM * nN, gid = wgid / nig, fm = gid * WGM, gsz = (nM - fm) < WGM ? (nM - fm) : WGM;
        u.pm = fm + ((wgid % nig) % gsz); u.pn = (wgid % nig) / gsz; return true;
    }
};
template <int MODE> struct EpiBf16 {
    static constexpr bool PERM = true;
    bf16_t* O; int ldc; const float* rs; const f32x2* tab;
    __device__ __forceinline__ void operator()(const f32x4 (&acc)[2][2][4][2], const Unit& u, int wr, int wc, int fr, int fq) const {
        const int row0 = u.pm * BM + wr * 64 + fr; const int col0 = u.pn * BM + wc * 32 + 8 * fq;
        bool rot[2]; int i0[2];
#pragma unroll
        for (int bj = 0; bj < 2; ++bj) { const int cm = (col0 + bj * HALF) % 192; rot[bj] = (MODE == 3) && cm >= 128; i0[bj] = rot[bj] ? (cm - 128) >> 1 : 0; }
#pragma unroll
        for (int am = 0; am < 4; ++am) { const int ai = am >> 1;
            f32x4 t0[4][2], t1[4][2]; float rsv[2][4];
#pragma unroll
            for (int m = 2 * (am & 1); m < 2 * (am & 1) + 2; ++m) rsv[ai][m] = (MODE >= 2) ? rs[row0 + ai * HALF + m * 16] : 1.f;
            if (MODE == 3) {
#pragma unroll
                for (int m = 2 * (am & 1); m < 2 * (am & 1) + 2; ++m)
#pragma unroll
                    for (int bj = 0; bj < 2; ++bj) { const f32x4* tp = (const f32x4*)(tab + (size_t)(row0 + ai * HALF + m * 16) * 32 + i0[bj]); t0[m][bj] = tp[0]; t1[m][bj] = tp[1];
                        if (!rot[bj]) { t0[m][bj] = (f32x4){1.f, 0.f, 1.f, 0.f}; t1[m][bj] = t0[m][bj]; } }
                asm volatile("" ::: "memory");
            }
#pragma unroll
            for (int m = 2 * (am & 1); m < 2 * (am & 1) + 2; ++m) { const int row = row0 + ai * HALF + m * 16; bf16_t* rowp = O + (size_t)row * ldc + col0;
                const float rsvv = rsv[ai][m];
#pragma unroll
                for (int bj = 0; bj < 2; ++bj) { f32x4 v0 = acc[ai][bj][m][0], v1 = acc[ai][bj][m][1];
                    if (MODE == 1) {
#pragma unroll
                        for (int e = 0; e < 4; ++e) { float a = fmaxf(v0[e], 0.f), b = fmaxf(v1[e], 0.f); v0[e] = a * a; v1[e] = b * b; } }
                    if (MODE >= 2) { v0 = v0 * rsvv; v1 = v1 * rsvv; }
                    if (MODE == 3) { const f32x4 a0 = t0[m][bj], a1 = t1[m][bj]; f32x4 w0, w1;
                        w0[0] = v0[0] * a0[0] - v0[1] * a0[1]; w0[1] = v0[1] * a0[0] + v0[0] * a0[1]; w0[2] = v0[2] * a0[2] - v0[3] * a0[3]; w0[3] = v0[3] * a0[2] + v0[2] * a0[3];
                        w1[0] = v1[0] * a1[0] - v1[1] * a1[1]; w1[1] = v1[1] * a1[0] + v1[0] * a1[1]; w1[2] = v1[2] * a1[2] - v1[3] * a1[3]; w1[3] = v1[3] * a1[2] + v1[2] * a1[3];
                        v0 = w0; v1 = w1; }
                    u32x4 w; w.x = cvtpk(v0[0], v0[1]); w.y = cvtpk(v0[2], v0[3]); w.z = cvtpk(v1[0], v1[1]); w.w = cvtpk(v1[2], v1[3]);
                    *(u32x4*)(rowp + bj * HALF) = w; } }
            if (MODE >= 2) asm volatile("" ::: "memory");
        }
    }
};
struct EpiRes {
    static constexpr bool PERM = false;
    const float* res; float* out; const float* gate; int ldc;
    __device__ __forceinline__ void operator()(const f32x4 (&acc)[2][2][4][2], const Unit& u, int wr, int wc, int fr, int fq) const {
        const int col0 = u.pn * BM + wc * 32 + 4 * fq;
        f32x4 gv[2][2];
#pragma unroll
        for (int bj = 0; bj < 2; ++bj)
#pragma unroll
            for (int n = 0; n < 2; ++n) gv[bj][n] = *(const f32x4*)(gate + col0 + bj * HALF + n * 16);
#pragma unroll
        for (int ai = 0; ai < 2; ++ai) {
            f32x4 bs[4][2][2];
#pragma unroll
            for (int m = 0; m < 4; ++m) { const size_t off = (size_t)(u.pm * BM + ai * HALF + wr * 64 + m * 16 + fr) * ldc + col0;
#pragma unroll
                for (int bj = 0; bj < 2; ++bj)
#pragma unroll
                    for (int n = 0; n < 2; ++n) bs[m][bj][n] = *(const f32x4*)(res + off + bj * HALF + n * 16); }
            asm volatile("" ::: "memory");
#pragma unroll
            for (int m = 0; m < 4; ++m) { const size_t off = (size_t)(u.pm * BM + ai * HALF + wr * 64 + m * 16 + fr) * ldc + col0;
#pragma unroll
                for (int bj = 0; bj < 2; ++bj)
#pragma unroll
                    for (int n = 0; n < 2; ++n) *(f32x4*)(out + off + bj * HALF + n * 16) = bs[m][bj][n] + gv[bj][n] * acc[ai][bj][m][n]; }
            asm volatile("" ::: "memory");
        }
    }
};

template <class Epi>
__device__ __forceinline__ void gemm_phase(LAS unsigned char* lds, const Gemm g, const StaticOrder& S, const Epi& E, int wave_s) {
    int tid_ = tid_of(wave_s);
    const int tid = tid_, wid = __builtin_amdgcn_readfirstlane(tid >> 6), lane = tid & 63, wr = wid >> 2, wc = wid & 3, fr = lane & 15, fq = lane >> 4;
    const int K = g.K, nt = K / BK;
    unsigned voffA[2], voffB[2];
#pragma unroll
    for (int i = 0; i < 2; ++i) { int R, C; stage_rc(tid * 16 + i * 8192, R, C); const int Rb = Epi::PERM ? ((R & ~31) + perm32(R & 31)) : R;
        voffA[i] = (unsigned)(R * g.lda + C) * 2u; voffB[i] = (unsigned)(Rb * K + C) * 2u; }
    const size_t kstep = (size_t)(BK * 2);
    const size_t hstepA = (size_t)HALF * g.lda * 2, hstepB = (size_t)HALF * K * 2;
    const size_t tstepA = 2 * hstepA, tstepB = 2 * hstepB;
    const unsigned ldsw = (unsigned)wid * 1024u;
    const int aoff = lds_byte(wr * 64 + fr, fq * 8), boff = lds_byte(wc * 32 + fr, fq * 8);
#define PG8_SA(b, h) (((b) * 2 + (h)) * HTB)
#define PG8_SB(b, h) ((4 + (b) * 2 + (h)) * HTB)
#define PG8_STAGE(bufoff, gbase, voff) do { _Pragma("unroll") for (int _i = 0; _i < 2; ++_i) \
        __builtin_amdgcn_global_load_lds((const unsigned*)((const char*)(gbase) + (voff)[_i]), (LAS unsigned*)(lds + (bufoff) + ldsw + _i * 8192), 16, 0, 0); } while (0)
#define PG8_LDA(dst, b, h) do { _Pragma("unroll") for (int m = 0; m < 4; ++m) _Pragma("unroll") for (int k = 0; k < 2; ++k) dst[m][k] = *(const LAS bf16x8*)(lds + PG8_SA(b, h) + aoff + m * 2048 + k * 1024); } while (0)
#define PG8_LDB(dst, b, h) do { _Pragma("unroll") for (int n = 0; n < 2; ++n) _Pragma("unroll") for (int k = 0; k < 2; ++k) dst[n][k] = *(const LAS bf16x8*)(lds + PG8_SB(b, h) + boff + n * 2048 + k * 1024); } while (0)
#define PG8_MMA(ai, bj, At, Bt) do { __builtin_amdgcn_s_setprio(1); _Pragma("unroll") for (int m = 0; m < 4; ++m) _Pragma("unroll") for (int n = 0; n < 2; ++n) _Pragma("unroll") for (int k = 0; k < 2; ++k) \
        acc[ai][bj][m][n] = __builtin_amdgcn_mfma_f32_16x16x32_bf16(Bt[n][k], At[m][k], acc[ai][bj][m][n], 0, 0, 0); __builtin_amdgcn_s_setprio(0); } while (0)
#define PG8_WAIT_V(n) asm volatile("s_waitcnt vmcnt(" #n ")" ::: "memory")
#define PG8_WAIT_L(n) asm volatile("s_waitcnt lgkmcnt(" #n ")" ::: "memory")
#define PG8_BAR __builtin_amdgcn_s_barrier()
#define PG8_SCHED __builtin_amdgcn_sched_barrier(0)
    Unit cur, nxt; int ui = 0;
    if (!S.next(0, cur)) return;
    f32x4 acc[2][2][4][2];
#pragma unroll
    for (int a = 0; a < 2; ++a)
#pragma unroll
        for (int b = 0; b < 2; ++b)
#pragma unroll
            for (int m = 0; m < 4; ++m)
#pragma unroll
                for (int n = 0; n < 2; ++n) acc[a][b][m][n] = (f32x4){0.f, 0.f, 0.f, 0.f};
    bf16x8 At[4][2], B0[2][2], B1[2][2];
    const char* cA = (const char*)g.A + (size_t)cur.pm * tstepA; const char* cB = (const char*)g.Bt + (size_t)cur.pn * tstepB;
    PG8_STAGE(PG8_SB(0, 0), cB, voffB); PG8_STAGE(PG8_SB(0, 1), cB + hstepB, voffB); PG8_STAGE(PG8_SA(0, 0), cA, voffA); PG8_STAGE(PG8_SA(0, 1), cA + hstepA, voffA);
    if (wr == 1) PG8_BAR;
    PG8_WAIT_V(2); PG8_BAR;
    PG8_STAGE(PG8_SB(1, 0), cB + kstep, voffB); PG8_STAGE(PG8_SA(1, 0), cA + kstep, voffA); PG8_STAGE(PG8_SB(1, 1), cB + hstepB + kstep, voffB);
    PG8_WAIT_V(6); PG8_BAR;
    for (;;) {
        const bool has_next = S.next(ui + 1, nxt);
        const char* nA = has_next ? (const char*)g.A + (size_t)nxt.pm * tstepA : cA; const char* nB = has_next ? (const char*)g.Bt + (size_t)nxt.pn * tstepB : cB;
        for (int t = 0; t < nt; t += 2) {
            const bool last = (t == nt - 2);
            const char* a1 = cA + (size_t)(t + 1) * kstep;
            const char* a2 = last ? nA : cA + (size_t)(t + 2) * kstep; const char* b2 = last ? nB : cB + (size_t)(t + 2) * kstep;
            const char* a3 = a2 + kstep; const char* b3 = b2 + kstep;
            PG8_LDB(B0, 0, 0); PG8_LDB(B1, 0, 1); PG8_SCHED; PG8_LDA(At, 0, 0); PG8_STAGE(PG8_SA(1, 1), a1 + hstepA, voffA);
            PG8_WAIT_V(8); PG8_WAIT_L(0); PG8_BAR; PG8_MMA(0, 0, At, B0); PG8_MMA(0, 1, At, B1); PG8_BAR; PG8_SCHED;
            PG8_LDA(At, 0, 1); PG8_STAGE(PG8_SB(0, 0), b2, voffB); PG8_STAGE(PG8_SB(0, 1), b2 + hstepB, voffB); PG8_STAGE(PG8_SA(0, 0), a2, voffA);
            PG8_WAIT_V(8); PG8_WAIT_L(0); PG8_BAR; PG8_MMA(1, 0, At, B0); PG8_MMA(1, 1, At, B1); PG8_BAR; PG8_SCHED;
            PG8_LDB(B0, 1, 0); PG8_LDB(B1, 1, 1); PG8_SCHED; PG8_LDA(At, 1, 0); PG8_STAGE(PG8_SA(0, 1), a2 + hstepA, voffA);
            PG8_WAIT_V(8); PG8_WAIT_L(0); PG8_BAR; PG8_MMA(0, 0, At, B0); PG8_MMA(0, 1, At, B1); PG8_BAR; PG8_SCHED;
            PG8_LDA(At, 1, 1); PG8_STAGE(PG8_SB(1, 0), b3, voffB); PG8_STAGE(PG8_SB(1, 1), b3 + hstepB, voffB); PG8_STAGE(PG8_SA(1, 0), a3, voffA);
            PG8_WAIT_V(8); PG8_WAIT_L(0); PG8_BAR; PG8_MMA(1, 0, At, B0); PG8_MMA(1, 1, At, B1); PG8_BAR; PG8_SCHED;
        }
        if (wr == 0) PG8_BAR;
        { const int l2_ = tid_of(wave_s) & 63; E(acc, cur, wr, wc, l2_ & 15, l2_ >> 4); }
        if (!has_next) break;
#pragma unroll
        for (int a = 0; a < 2; ++a)
#pragma unroll
            for (int b = 0; b < 2; ++b)
#pragma unroll
                for (int m = 0; m < 4; ++m)
#pragma unroll
                    for (int n = 0; n < 2; ++n) acc[a][b][m][n] = (f32x4){0.f, 0.f, 0.f, 0.f};
        cur = nxt; cA = nA; cB = nB; ++ui;
        if (wr == 1) PG8_BAR;
    }
    PG8_WAIT_V(0);
    PG8_BAR;
#undef PG8_SA
#undef PG8_SB
#undef PG8_STAGE
#undef PG8_LDA
#undef PG8_LDB
#undef PG8_MMA
#undef PG8_WAIT_V
#undef PG8_WAIT_L
#undef PG8_BAR
#undef PG8_SCHED
}
}

namespace att {
constexpr int NW = 8, QBLK = 32, KVBLK = 64;
constexpr int SHM_V = KVBLK * 128 * 2;
constexpr int SHM_KMAX = KVBLK * 384;
constexpr int OFF_K = 0, OFF_V = 3 * SHM_KMAX, OFF_WS = OFF_V + 4 * SHM_V, OFF_LUT = OFF_WS + NW * 256, ATT_LDS = OFF_LUT + 2048;
constexpr float THR2 = 11.5f;
#define SBAR() __builtin_amdgcn_sched_barrier(0)
__device__ __forceinline__ int crow(int r, int hi) { return (r & 3) + 8 * (r >> 2) + 4 * hi; }
__device__ __forceinline__ int v_st(int k, int c) { const int kk = (k & ~0xC) | ((k & 4) << 1) | ((k & 8) >> 1); return ((kk >> 3) * 4 + (c >> 5)) * 512 + ((kk & 7) * 32 + (c & 31)) * 2; }
__device__ __forceinline__ int v_rd_base(int lane) { return ((lane & 3) << 3) | (((lane >> 2) & 3) << 6) | (((lane >> 4) & 1) << 5) | (((lane >> 5) & 1) << 8); }
constexpr int v_rd_off(int d0, int ks, int half) { return d0 * 512 + ks * 4096 + half * 2048; }
template <int OFF> __device__ __forceinline__ s16x4 tr_read(int vb) {
    s16x4 r; asm volatile("ds_read_b64_tr_b16 %0, %1 offset:%2" : "=&v"(r) : "v"(vb), "i"(OFF) : "memory"); return r;
}
template <int D0> __device__ __forceinline__ void pv_one(f32x16& od, int vb, bf16x8 pa0, bf16x8 pa1, bf16x8 pa2, bf16x8 pa3) {
    const s16x4 l0 = tr_read<v_rd_off(D0, 0, 0)>(vb), h0 = tr_read<v_rd_off(D0, 0, 1)>(vb), l1 = tr_read<v_rd_off(D0, 1, 0)>(vb), h1 = tr_read<v_rd_off(D0, 1, 1)>(vb);
    const s16x4 l2 = tr_read<v_rd_off(D0, 2, 0)>(vb), h2 = tr_read<v_rd_off(D0, 2, 1)>(vb), l3 = tr_read<v_rd_off(D0, 3, 0)>(vb), h3 = tr_read<v_rd_off(D0, 3, 1)>(vb);
    asm volatile("s_waitcnt lgkmcnt(0)" ::: "memory"); SBAR();
#define PK(L, H) (bf16x8){L[0], L[1], L[2], L[3], H[0], H[1], H[2], H[3]}
    od = __builtin_amdgcn_mfma_f32_32x32x16_bf16(pa0, PK(l0, h0), od, 0, 0, 0);
    od = __builtin_amdgcn_mfma_f32_32x32x16_bf16(pa1, PK(l1, h1), od, 0, 0, 0);
    od = __builtin_amdgcn_mfma_f32_32x32x16_bf16(pa2, PK(l2, h2), od, 0, 0, 0);
    od = __builtin_amdgcn_mfma_f32_32x32x16_bf16(pa3, PK(l3, h3), od, 0, 0, 0);
#undef PK
}
template <bool RSM> __device__ __forceinline__ void pv_d0(f32x16* o, f32x16& lacc, int vb, bf16x8 pa0, bf16x8 pa1, bf16x8 pa2, bf16x8 pa3) {
    if (RSM) {
        const bf16x8 ones = {0x3F80, 0x3F80, 0x3F80, 0x3F80, 0x3F80, 0x3F80, 0x3F80, 0x3F80};
        lacc = __builtin_amdgcn_mfma_f32_32x32x16_bf16(pa0, ones, lacc, 0, 0, 0);
        lacc = __builtin_amdgcn_mfma_f32_32x32x16_bf16(pa1, ones, lacc, 0, 0, 0);
        lacc = __builtin_amdgcn_mfma_f32_32x32x16_bf16(pa2, ones, lacc, 0, 0, 0);
        lacc = __builtin_amdgcn_mfma_f32_32x32x16_bf16(pa3, ones, lacc, 0, 0, 0); }
    pv_one<0>(o[0], vb, pa0, pa1, pa2, pa3); pv_one<1>(o[1], vb, pa0, pa1, pa2, pa3); pv_one<2>(o[2], vb, pa0, pa1, pa2, pa3); pv_one<3>(o[3], vb, pa0, pa1, pa2, pa3);
}
template <int MODE, bool FIRST, bool FOLD>
__device__ __forceinline__ bool partialSM(f32x16& p0, f32x16& p1, float& m_reg, float& alpha, int relbase, bool near, const float* lut, float cb) {
    if (!FOLD) { const float off_ = cb - m_reg;
#pragma unroll
        for (int r = 0; r < 16; ++r) { p0[r] += off_; p1[r] += off_; } }
    if (MODE != 0 && near) {
#pragma unroll
        for (int r = 0; r < 16; ++r) { const int rel = relbase + (r & 3) + 8 * (r >> 2), rel1 = rel + 32;
            const int i0 = min(max(rel, -128), 128) + 128, i1 = min(max(rel1, -128), 128) + 128;
            const float b0 = lut[i0], b1 = lut[i1];
            if (MODE == 1) { p0[r] += b0; p1[r] += b1; }
            else { p0[r] = (rel >= -128 && rel <= 128) ? p0[r] + b0 : -1e30f; p1[r] = (rel1 >= -128 && rel1 <= 128) ? p1[r] + b1 : -1e30f; } }
    }
    float pmax = p0[0];
#pragma unroll
    for (int r = 1; r < 16; ++r) pmax = fmaxf(pmax, p0[r]);
#pragma unroll
    for (int r = 0; r < 16; ++r) pmax = fmaxf(pmax, p1[r]);
    { auto rr = __builtin_amdgcn_permlane32_swap(__float_as_uint(pmax), __float_as_uint(pmax), false, false);
      pmax = fmaxf(__uint_as_float(rr[0]), __uint_as_float(rr[1])); }
    bool resc;
    if (FIRST && MODE != 2) resc = true; else resc = __any(pmax > THR2);
    if (__builtin_expect(resc, FIRST && MODE != 2)) {
        const float delta = (FIRST && MODE != 2) ? pmax : fmaxf(pmax, 0.f);
        m_reg += delta; alpha = (FIRST && MODE != 2) ? 1.f : __builtin_amdgcn_exp2f(-delta);
#pragma unroll
        for (int r = 0; r < 16; ++r) { p0[r] -= delta; p1[r] -= delta; }
    } else alpha = 1.f;
#pragma unroll
    for (int r = 0; r < 16; ++r) p0[r] = __builtin_amdgcn_exp2f(p0[r]);
    return resc;
}
template <bool RSM> __device__ __forceinline__ void finishSM(f32x16& p0, f32x16& p1, float& l_reg, bf16x8& pa0, bf16x8& pa1, bf16x8& pa2, bf16x8& pa3) {
#pragma unroll
    for (int r = 0; r < 16; ++r) p1[r] = __builtin_amdgcn_exp2f(p1[r]);
    float ps = 0;
    if (!RSM) {
#pragma unroll
    for (int r = 0; r < 16; ++r) ps += p0[r];
#pragma unroll
    for (int r = 0; r < 16; ++r) ps += p1[r];
    { auto rr = __builtin_amdgcn_permlane32_swap(__float_as_uint(ps), __float_as_uint(ps), false, false);
      ps = __uint_as_float(rr[0]) + __uint_as_float(rr[1]); }
    l_reg += ps; }
#define PK4(P, BASE, OUT) do { u32x4 w = {cvtpk(P[BASE + 0], P[BASE + 1]), cvtpk(P[BASE + 2], P[BASE + 3]), cvtpk(P[BASE + 4], P[BASE + 5]), cvtpk(P[BASE + 6], P[BASE + 7])}; \
    OUT = *reinterpret_cast<bf16x8*>(&w); } while (0)
    PK4(p0, 0, pa0); PK4(p0, 8, pa1); PK4(p1, 0, pa2); PK4(p1, 8, pa3);
#undef PK4
}
template <int OFF> __device__ __forceinline__ bf16x8 lds_rd128(int addr) {
    bf16x8 r; asm volatile("ds_read_b128 %0, %1 offset:%2" : "=&v"(r) : "v"(addr), "i"(OFF) : "memory"); return r;
}
#define PK4X(P, BASE, OUT) do { u32x4 w = {cvtpk(P[BASE + 0], P[BASE + 1]), cvtpk(P[BASE + 2], P[BASE + 3]), cvtpk(P[BASE + 4], P[BASE + 5]), cvtpk(P[BASE + 6], P[BASE + 7])}; \
    OUT = *reinterpret_cast<bf16x8*>(&w); } while (0)
template <int S, bool RSM> __device__ __forceinline__ void fsm_step(f32x16& pc0, f32x16& pc1, float& ps, float& l_reg, bf16x8& pa0, bf16x8& pa1, bf16x8& pa2, bf16x8& pa3) {
    if (S < 4) {
#pragma unroll
        for (int r = 0; r < 4; ++r) pc1[4 * S + r] = __builtin_amdgcn_exp2f(pc1[4 * S + r]); }
    if (S == 4) { PK4X(pc0, 0, pa0); if (!RSM) ps = ((pc0[0] + pc0[1]) + (pc0[2] + pc0[3])) + ((pc0[4] + pc0[5]) + (pc0[6] + pc0[7])); }
    if (S == 5) { PK4X(pc0, 8, pa1); if (!RSM) ps += ((pc0[8] + pc0[9]) + (pc0[10] + pc0[11])) + ((pc0[12] + pc0[13]) + (pc0[14] + pc0[15])); }
    if (S == 6) { PK4X(pc1, 0, pa2); if (!RSM) ps += ((pc1[0] + pc1[1]) + (pc1[2] + pc1[3])) + ((pc1[4] + pc1[5]) + (pc1[6] + pc1[7])); }
    if (S == 7 && RSM) PK4X(pc1, 8, pa3);
    if (S == 7 && !RSM) { PK4X(pc1, 8, pa3); ps += ((pc1[8] + pc1[9]) + (pc1[10] + pc1[11])) + ((pc1[12] + pc1[13]) + (pc1[14] + pc1[15]));
        auto rr = __builtin_amdgcn_permlane32_swap(__float_as_uint(ps), __float_as_uint(ps), false, false); l_reg += __uint_as_float(rr[0]) + __uint_as_float(rr[1]); }
}
template <int NQ, int I> __device__ __forceinline__ void krd_pair(bf16x8& f0, bf16x8& f1, int ka, const int (&kb1)[2], const int (&kb2)[2]) {
    constexpr bool HAS1 = NQ >= 8; constexpr int SHM_K1 = HAS1 ? 16384 : 0, NP1 = HAS1 ? 8 : 0;
    if (I < NP1) { const int a_ = ka + kb1[0] + (((I < 8 ? I : 0) ^ kb1[1]) << 5); f0 = lds_rd128<0>(a_); f1 = lds_rd128<8192>(a_); }
    else { const int a_ = ka + kb2[0] + ((((I - NP1) & 3) ^ kb2[1]) << 5); f0 = lds_rd128<SHM_K1>(a_); f1 = lds_rd128<SHM_K1 + 4096>(a_); }
}
template <int NQ, int I> __device__ __forceinline__ void qk_slot(f32x16& pn0, f32x16& pn1, f32x16& pc0, f32x16& pc1, float& ps, float& l_reg, bf16x8& pa0, bf16x8& pa1, bf16x8& pa2, bf16x8& pa3,
                                                                   bf16x8 (&kf0)[3], bf16x8 (&kf1)[3], int ka, const int (&kb1)[2], const int (&kb2)[2], const bf16x8* qr, const f32x16& cinit) {
    constexpr int AH = 1, RING = AH + 1;
    if (I + AH < NQ) krd_pair<NQ, (I + AH < NQ ? I + AH : 0)>(kf0[(I + AH) % RING], kf1[(I + AH) % RING], ka, kb1, kb2);
    constexpr int LEFT = (NQ - 1 - I) < AH ? (NQ - 1 - I) : AH;
    if (LEFT == 2) asm volatile("s_waitcnt lgkmcnt(4)" ::: "memory"); else if (LEFT == 1) asm volatile("s_waitcnt lgkmcnt(2)" ::: "memory"); else asm volatile("s_waitcnt lgkmcnt(0)" ::: "memory");
    SBAR();
    if (I == 0) { pn0 = __builtin_amdgcn_mfma_f32_32x32x16_bf16(kf0[0], qr[0], cinit, 0, 0, 0); pn1 = __builtin_amdgcn_mfma_f32_32x32x16_bf16(kf1[0], qr[0], cinit, 0, 0, 0); }
    else { pn0 = __builtin_amdgcn_mfma_f32_32x32x16_bf16(kf0[I % RING], qr[I], pn0, 0, 0, 0); pn1 = __builtin_amdgcn_mfma_f32_32x32x16_bf16(kf1[I % RING], qr[I], pn1, 0, 0, 0); }
    if (NQ == 4) { fsm_step<2 * I, (NQ == 4)>(pc0, pc1, ps, l_reg, pa0, pa1, pa2, pa3); fsm_step<2 * I + 1, (NQ == 4)>(pc0, pc1, ps, l_reg, pa0, pa1, pa2, pa3); }
    else if (I < 8) fsm_step<(I < 8 ? I : 0), (NQ == 4)>(pc0, pc1, ps, l_reg, pa0, pa1, pa2, pa3);
    SBAR();
}
template <int NQ>
__device__ __forceinline__ void qk_fsm(f32x16& pn0, f32x16& pn1, f32x16& pc0, f32x16& pc1, float& l_reg, bf16x8& pa0, bf16x8& pa1, bf16x8& pa2, bf16x8& pa3,
                                       int ka, const int (&kb1)[2], const int (&kb2)[2], const bf16x8* qr, const f32x16& cinit, bf16x8 kfp0, bf16x8 kfp1) {
    bf16x8 kf0[3], kf1[3]; float ps = 0.f;
    if (NQ != 12) {
        kf0[0] = kfp0; kf1[0] = kfp1;
        asm volatile("" : "+v"(kf0[0]), "+v"(kf1[0]));
    }
    asm volatile("s_waitcnt lgkmcnt(0)" ::: "memory"); SBAR();
    if (NQ == 12) krd_pair<NQ, 0>(kf0[0], kf1[0], ka, kb1, kb2);
    qk_slot<NQ, 0>(pn0, pn1, pc0, pc1, ps, l_reg, pa0, pa1, pa2, pa3, kf0, kf1, ka, kb1, kb2, qr, cinit);
    qk_slot<NQ, 1>(pn0, pn1, pc0, pc1, ps, l_reg, pa0, pa1, pa2, pa3, kf0, kf1, ka, kb1, kb2, qr, cinit);
    qk_slot<NQ, 2>(pn0, pn1, pc0, pc1, ps, l_reg, pa0, pa1, pa2, pa3, kf0, kf1, ka, kb1, kb2, qr, cinit);
    qk_slot<NQ, 3>(pn0, pn1, pc0, pc1, ps, l_reg, pa0, pa1, pa2, pa3, kf0, kf1, ka, kb1, kb2, qr, cinit);
    if (NQ >= 8) {
        qk_slot<NQ, 4>(pn0, pn1, pc0, pc1, ps, l_reg, pa0, pa1, pa2, pa3, kf0, kf1, ka, kb1, kb2, qr, cinit);
        qk_slot<NQ, 5>(pn0, pn1, pc0, pc1, ps, l_reg, pa0, pa1, pa2, pa3, kf0, kf1, ka, kb1, kb2, qr, cinit);
        qk_slot<NQ, 6>(pn0, pn1, pc0, pc1, ps, l_reg, pa0, pa1, pa2, pa3, kf0, kf1, ka, kb1, kb2, qr, cinit);
        qk_slot<NQ, 7>(pn0, pn1, pc0, pc1, ps, l_reg, pa0, pa1, pa2, pa3, kf0, kf1, ka, kb1, kb2, qr, cinit); }
    if (NQ == 12) {
        qk_slot<NQ, 8>(pn0, pn1, pc0, pc1, ps, l_reg, pa0, pa1, pa2, pa3, kf0, kf1, ka, kb1, kb2, qr, cinit);
        qk_slot<NQ, 9>(pn0, pn1, pc0, pc1, ps, l_reg, pa0, pa1, pa2, pa3, kf0, kf1, ka, kb1, kb2, qr, cinit);
        qk_slot<NQ, 10>(pn0, pn1, pc0, pc1, ps, l_reg, pa0, pa1, pa2, pa3, kf0, kf1, ka, kb1, kb2, qr, cinit);
        qk_slot<NQ, 11>(pn0, pn1, pc0, pc1, ps, l_reg, pa0, pa1, pa2, pa3, kf0, kf1, ka, kb1, kb2, qr, cinit); }
}
template <int NQ>
__device__ __forceinline__ void qkt(f32x16& p0, f32x16& p1, const char* Ks, const int (&kq1)[2], const int (&kq2)[2], const bf16x8* qr, const f32x16& cinit) {
    int kb1[8], kb2[4];
#pragma unroll
    for (int i = 0; i < 8; ++i) kb1[i] = kq1[0] + ((i ^ kq1[1]) << 5);
#pragma unroll
    for (int i = 0; i < 4; ++i) kb2[i] = kq2[0] + ((i ^ kq2[1]) << 5);
    constexpr bool HAS1 = NQ >= 8, HAS2 = NQ != 8; constexpr int SHM_K1 = HAS1 ? 16384 : 0;
    p0 = cinit; p1 = cinit;
    if (HAS1) {
#pragma unroll
        for (int d0 = 0; d0 < 8; ++d0) { const char* a = Ks + kb1[d0];
            const bf16x8 b0 = *reinterpret_cast<const bf16x8*>(a); const bf16x8 b1 = *reinterpret_cast<const bf16x8*>(a + 8192);
            p0 = __builtin_amdgcn_mfma_f32_32x32x16_bf16(b0, qr[d0], p0, 0, 0, 0);
            p1 = __builtin_amdgcn_mfma_f32_32x32x16_bf16(b1, qr[d0], p1, 0, 0, 0); } }
    if (HAS2) {
#pragma unroll
        for (int d = 0; d < 4; ++d) { const char* a = Ks + SHM_K1 + kb2[d];
            const bf16x8 b0 = *reinterpret_cast<const bf16x8*>(a); const bf16x8 b1 = *reinterpret_cast<const bf16x8*>(a + 4096);
            p0 = __builtin_amdgcn_mfma_f32_32x32x16_bf16(b0, qr[(NQ == 12 ? 8 : 0) + d], p0, 0, 0, 0);
            p1 = __builtin_amdgcn_mfma_f32_32x32x16_bf16(b1, qr[(NQ == 12 ? 8 : 0) + d], p1, 0, 0, 0); } }
}
template <int NQ, int MODE>
__device__ __forceinline__ void attn_core(const bf16_t* __restrict__ Qb, int ldq, const bf16_t* __restrict__ K0, int ldk0, const bf16_t* __restrict__ K1, int ldk1,
                                          const bf16_t* __restrict__ Vh, int ldv, int kt0, int NT, int q0, const float* lut, float cbL, float cbR, float m_init, float l_init,
                                          char* lds, f32x16 (&o)[4], int wave_s) {
    constexpr bool HAS1 = NQ >= 8, HAS2 = NQ != 8;
    constexpr int SHM_K1 = HAS1 ? 16384 : 0, SHM_K2 = HAS2 ? 8192 : 0, SHM_KT = SHM_K1 + SHM_K2;
    constexpr int NLK = (HAS1 ? 2 : 0) + (HAS2 ? 1 : 0), NLV = 2, NL = NLK + NLV;
    constexpr bool FOLD = (NQ != 12 && MODE != 2);
    int tid_ = tid_of(wave_s);
    const int tid = tid_, wid = wave_s, lane = tid & 63, r32 = lane & 31, hi = lane >> 5;
    char* K_lds = lds + OFF_K; char* V_lds = lds + OFF_V;
    float* ws = (float*)(lds + OFF_WS) + wid * 64; float* li_l = ws; float* al_l = ws + 32;
    constexpr bool RSM = (NQ == 4);
    float m_reg = m_init, l_reg = l_init;
    f32x16 lacc;
#pragma unroll
    for (int r = 0; r < 16; ++r) lacc[r] = l_init;
#pragma unroll
    for (int d = 0; d < 4; ++d) o[d] = f32x16{};
    const int ldk2 = (NQ == 4) ? ldk0 : ldk1; const bf16_t* K2 = (NQ == 4) ? K0 : K1;
    unsigned voK1[2], voK2, voV[2];
#pragma unroll
    for (int i = 0; i < 2; ++i) { const int p = wid + 8 * i, row = 4 * p + (lane >> 4), cbs = (lane & 15) ^ (row & 15); voK1[i] = (unsigned)(row * ldk0 + cbs * 8) * 2u; }
    { const int row = 8 * wid + (lane >> 3), cbs = (lane & 7) ^ ((row >> 1) & 7); voK2 = (unsigned)(row * ldk2 + cbs * 8) * 2u; }
#pragma unroll
    for (int i = 0; i < 2; ++i) { const int p = wid + 8 * i, sub = 2 * p + (lane >> 5), kk = ((sub >> 2) << 3) | ((lane & 31) >> 2);
        const int k = kk, c = (sub & 3) * 32 + (lane & 3) * 8; voV[i] = (unsigned)(k * ldv + c) * 2u; }
    const char* gK1 = (const char*)(K0 + (size_t)kt0 * KVBLK * ldk0); const size_t stK1 = (size_t)KVBLK * ldk0 * 2;
    const char* gK2 = (const char*)(K2 + (size_t)kt0 * KVBLK * ldk2); const size_t stK2 = (size_t)KVBLK * ldk2 * 2;
    const char* gV = (const char*)(Vh + (size_t)kt0 * KVBLK * ldv); const size_t stV = (size_t)KVBLK * ldv * 2;
    LAS unsigned char* K3 = (LAS unsigned char*)K_lds; LAS unsigned char* V3 = (LAS unsigned char*)V_lds;
#define GLDS(g, l) __builtin_amdgcn_global_load_lds((const unsigned*)(g), (LAS unsigned*)(l), 16, 0, 0)
#define DMA_K(t, st) do { if (HAS1) { GLDS(gK1 + (size_t)(t) * stK1 + voK1[0], K3 + (st) * SHM_KT + wid * 1024); GLDS(gK1 + (size_t)(t) * stK1 + voK1[1], K3 + (st) * SHM_KT + (wid + 8) * 1024); } \
    if (HAS2) GLDS(gK2 + (size_t)(t) * stK2 + voK2, K3 + (st) * SHM_KT + SHM_K1 + wid * 1024); } while (0)
#define DMA_V(t, st) do { GLDS(gV + (size_t)(t) * stV + voV[0], V3 + (st) * SHM_V + wid * 1024); GLDS(gV + (size_t)(t) * stV + voV[1], V3 + (st) * SHM_V + (wid + 8) * 1024); } while (0)
#define WAIT_BAR(N) asm volatile("s_waitcnt vmcnt(" #N ") lgkmcnt(0)\n\ts_barrier" ::: "memory")
#define WAITB(n) do { if ((n) == 0) WAIT_BAR(0); else if ((n) == 1) WAIT_BAR(1); else if ((n) == 2) WAIT_BAR(2); else if ((n) == 3) WAIT_BAR(3); else if ((n) == 4) WAIT_BAR(4); else WAIT_BAR(5); } while (0)
    bf16x8 qr[NQ];
    const bf16_t* Qw = Qb + (long)(wid * QBLK + r32) * ldq + hi * 8;
    __syncthreads();
#pragma unroll
    for (int d0 = 0; d0 < NQ; ++d0) qr[d0] = *reinterpret_cast<const bf16x8*>(Qw + d0 * 16);
    DMA_K(0, 0); DMA_V(0, 0); DMA_K(1, 1);
    const int lo1 = (hi ^ (r32 & 1)) << 4, s3 = (r32 >> 1) & 7, b1_ = r32 * 256 + lo1;
    const int kb1[2] = {b1_, s3};
    const int lo2 = (hi ^ ((r32 >> 1) & 1)) << 4, s2 = (r32 >> 2) & 3, b2_ = r32 * 128 + lo2;
    const int kb2[2] = {b2_, s2};
    const int vb0 = (int)(uintptr_t)V_lds + v_rd_base(lane);
    const int kl0 = (int)(uintptr_t)K_lds;
    const int qw = q0 + wid * QBLK;
#define RESC(a, rs) do { if (__builtin_expect((rs), 0)) { if (hi == 0) al_l[r32] = (a); asm volatile("s_waitcnt lgkmcnt(0)" ::: "memory"); \
    _Pragma("unroll") for (int r = 0; r < 16; ++r) { const float al_ = al_l[crow(r, hi)]; if (RSM) lacc[r] *= al_; _Pragma("unroll") for (int d = 0; d < 4; ++d) o[d][r] *= al_; } } l_reg *= (a); } while (0)
#define TILEP(t) const int k0t = (kt0 + (t)) * KVBLK; const int relb = k0t - qw - r32 + 4 * hi; \
    const bool nearT = (MODE == 2) ? true : ((MODE == 1) ? !(k0t + 154 <= qw || k0t >= qw + 122) : false); \
    const float cbT = (MODE == 1 && !nearT) ? (k0t < qw ? cbL : cbR) : 0.f;
    f32x16 cinit = f32x16{}; float cur_cb = 0.f; bool dirty = true;
#define CINIT(t) do { TILEP(t); (void)relb; if (FOLD && __builtin_expect(dirty || cbT != cur_cb, 0)) { const float v_ = cbT - m_reg; _Pragma("unroll") for (int r = 0; r < 16; ++r) cinit[r] = v_; asm volatile("" : "+v"(cinit)); cur_cb = cbT; dirty = false; } } while (0)
    f32x16 pA0, pA1, pB0, pB1; float alA, alB; bool rsA, rsB; bf16x8 pa0, pa1, pa2, pa3;
    WAITB(NLK);
    if (2 < NT) DMA_K(2, 2); DMA_V(1, 1);
    CINIT(0);
    qkt<NQ>(pA0, pA1, K_lds, kb1, kb2, qr, cinit); { TILEP(0); (void)cbT; rsA = partialSM<MODE, true, FOLD>(pA0, pA1, m_reg, alA, relb, nearT, lut, cbT); dirty |= rsA; }
    l_reg *= alA;
    if (2 < NT) WAITB(NL); else WAITB(NLV);
#define grp1 (wid >= 4)
    int kc = 1, vp = 0;
#define KST(x) ((x) >= 3 ? (x) - 3 : (x))
#define VST(x) ((x) >= 4 ? (x) - 4 : (x))
    bf16x8 kfp0 = {}, kfp1 = {};
#define KPRE(st) do { if (NQ == 12) break; const char* kp_ = K_lds + (st) * SHM_KT; if (HAS1) { const int a_ = kb1[0] + (kb1[1] << 5); kfp0 = *reinterpret_cast<const bf16x8*>(kp_ + a_); kfp1 = *reinterpret_cast<const bf16x8*>(kp_ + a_ + 8192); } \
    else { const int a_ = kb2[0] + (kb2[1] << 5); kfp0 = *reinterpret_cast<const bf16x8*>(kp_ + a_); kfp1 = *reinterpret_cast<const bf16x8*>(kp_ + a_ + 4096); } SBAR(); } while (0)
#define EVENT(jj) do { if (__builtin_expect((jj) + 3 < NT, 1)) { WAITB(NL); DMA_K((jj) + 3, kc); DMA_V((jj) + 2, VST(vp + 3)); }     \
    else if ((jj) + 3 == NT) { WAITB(NL); DMA_V((jj) + 2, VST(vp + 3)); } else { WAITB(NLV); } } while (0)
#define STEP(C0, C1, P0, P1, alC, rsC, jj) do { \
    SBAR(); qk_fsm<NQ>(C0, C1, P0, P1, l_reg, pa0, pa1, pa2, pa3, kl0 + kc * SHM_KT, kb1, kb2, qr, cinit, kfp0, kfp1); SBAR(); \
    if (grp1) EVENT(jj); \
    pv_d0<RSM>(o, lacc, vb0 + vp * SHM_V, pa0, pa1, pa2, pa3); \
    if (!grp1) EVENT(jj); \
    kc = KST(kc + 1); vp = VST(vp + 1); \
    KPRE(kc); \
    { TILEP(jj); (void)cbT; rsC = partialSM<MODE, false, FOLD>(C0, C1, m_reg, alC, relb, nearT, lut, cbT); dirty |= rsC; } \
    RESC(alC, rsC); CINIT((jj) + 1); } while (0)
    DMA_K(3, 0); DMA_V(2, 2);
    KPRE(kc); CINIT(1);
    for (int j = 1; j + 1 < NT; j += 2) {
        STEP(pB0, pB1, pA0, pA1, alB, rsB, j);
        STEP(pA0, pA1, pB0, pB1, alA, rsA, j + 1);
    }
    SBAR(); qk_fsm<NQ>(pB0, pB1, pA0, pA1, l_reg, pa0, pa1, pa2, pa3, kl0 + kc * SHM_KT, kb1, kb2, qr, cinit, kfp0, kfp1); SBAR();
    if (grp1) WAITB(0);
    pv_d0<RSM>(o, lacc, vb0 + vp * SHM_V, pa0, pa1, pa2, pa3);
    if (!grp1) WAITB(0);
    { TILEP(NT - 1); (void)cbT; rsB = partialSM<MODE, false, FOLD>(pB0, pB1, m_reg, alB, relb, nearT, lut, cbT); }
    RESC(alB, rsB);
    finishSM<RSM>(pB0, pB1, l_reg, pa0, pa1, pa2, pa3); SBAR();
    pv_d0<RSM>(o, lacc, vb0 + VST(vp + 1) * SHM_V, pa0, pa1, pa2, pa3);
    (void)alA;
    if (hi == 0) li_l[r32] = l_reg; asm volatile("s_waitcnt lgkmcnt(0)" ::: "memory");
#pragma unroll
    for (int r = 0; r < 16; ++r) { const float rl = __builtin_amdgcn_rcpf(RSM ? lacc[r] : li_l[crow(r, hi)]);
#pragma unroll
        for (int d = 0; d < 4; ++d) o[d][r] *= rl; }
#undef GLDS
#undef DMA_K
#undef DMA_V
#undef WAIT_BAR
#undef WAITB
#undef RESC
#undef TILEP
#undef CINIT
#undef KPRE
#undef EVENT
#undef STEP
#undef grp1
#undef KST
#undef VST
}
#undef SBAR
}


#define XB_TMO      128
#define XB_XCNT(j)  (256  + 64 * (j))
#define XB_XSUB(j)  (1280 + 64 * (j))
#define XB_XGEN(j)  (2304 + 64 * (j))
#define XB_TOP      3328
#define XB_TOPGEN   3392
#define XCD_BAR_WORDS 3456
#define XB_SPIN_CAP (1u << 22)
__device__ __forceinline__ unsigned xb_ld(unsigned* p)              { return __hip_atomic_load(p, __ATOMIC_RELAXED, __HIP_MEMORY_SCOPE_AGENT); }
__device__ __forceinline__ unsigned xb_add(unsigned* p, unsigned v) { return __hip_atomic_fetch_add(p, v, __ATOMIC_RELAXED, __HIP_MEMORY_SCOPE_AGENT); }
__device__ __forceinline__ unsigned xb_xcc_id() { return (unsigned)__builtin_amdgcn_s_getreg((3 << 11) | 20) & 0xFu; }
#define XB_SPIN(cond, bar) do { unsigned _sp = 0; while (cond) { __builtin_amdgcn_s_sleep(1); \
    if ((++_sp & 255u) == 0u) { if (xb_ld(&(bar)[XB_TMO])) break; if (_sp > XB_SPIN_CAP) { atomicAdd(&(bar)[XB_TMO], 1u); break; } } } } while (0)
struct XcdBarrier { unsigned* bar; unsigned x; volatile LAS unsigned* st; };
__device__ __forceinline__ XcdBarrier xcd_barrier_post(unsigned* bar, volatile LAS unsigned* st, bool tid0) {
    XcdBarrier b; b.bar = bar; b.x = xb_xcc_id(); b.st = st;
    if (tid0) (void)xb_add(&bar[XB_XCNT(b.x)], 1u);
    return b;
}
__device__ __forceinline__ void xcd_barrier_complete(unsigned* bar, unsigned x, unsigned& nloc, unsigned& nx) {
    const unsigned G = gridDim.x * gridDim.y * gridDim.z;
    unsigned sum, cnt, mine, sp = 0u;
    for (;;) {
        sum = 0u; cnt = 0u; mine = 0u;
#pragma unroll
        for (unsigned j = 0; j < 16; ++j) { const unsigned c = xb_ld(&bar[XB_XCNT(j)]); sum += c; cnt += (c > 0u) ? 1u : 0u; mine = (j == x) ? c : mine; }
        if (sum == G) break;
        __builtin_amdgcn_s_sleep(1);
        if ((++sp & 255u) == 0u) { if (xb_ld(&bar[XB_TMO])) break; if (sp > XB_SPIN_CAP) { atomicAdd(&bar[XB_TMO], 1u); break; } }
    }
    nloc = mine > 0u ? mine : 1u; nx = cnt > 0u ? cnt : 1u;
}
__device__ __forceinline__ void xcd_barrier(const XcdBarrier& b, int wave_s) {
    asm volatile("s_waitcnt vmcnt(0)" ::: "memory");
    __syncthreads();
    if (tid_of(wave_s) == 0) {
        unsigned* bar = b.bar;
        __builtin_amdgcn_s_waitcnt(0);
        unsigned nloc = b.st[0], nx = b.st[1];
        if (nloc == 0u) { xcd_barrier_complete(bar, b.x, nloc, nx); b.st[0] = nloc; b.st[1] = nx; }
        const unsigned old = xb_add(&bar[XB_XSUB(b.x)], 1u);
        const unsigned gen = old / nloc;
        if (old + 1u == (gen + 1u) * nloc) {
            __builtin_amdgcn_fence(__ATOMIC_RELEASE, "agent");
            asm volatile("s_waitcnt vmcnt(0)" ::: "memory");
            const unsigned og = xb_add(&bar[XB_TOP], 1u);
            const unsigned tg = og / nx;
            if (og + 1u == (tg + 1u) * nx) xb_add(&bar[XB_TOPGEN], 1u);
            else XB_SPIN(xb_ld(&bar[XB_TOPGEN]) == tg, bar);
            __builtin_amdgcn_fence(__ATOMIC_ACQUIRE, "agent");
            xb_add(&bar[XB_XGEN(b.x)], 1u);
            asm volatile("s_waitcnt vmcnt(0)" ::: "memory");
        } else {
            XB_SPIN(xb_ld(&bar[XB_XGEN(b.x)]) == gen, bar);
            __builtin_amdgcn_fence(__ATOMIC_ACQUIRE, "agent");
            asm volatile("s_waitcnt vmcnt(0)" ::: "memory");
        }
    }
    __syncthreads();
}

constexpr int NWAVES = 8, NTHR = 512;
constexpr int LDS_BYTES = 147456;
constexpr int MISC_OFF = 146432;
static_assert(att::ATT_LDS <= MISC_OFF && pg8::STAGE_BYTES <= MISC_OFF && MISC_OFF + 16 <= LDS_BYTES, "LDS map");

struct Args {
    const float* x; const float* c; const float* w_ada; const float* b_ada; const float* norm1; const float* w_in; const float* a_q_norm; const float* a_k_norm;
    const float* b_q_norm; const float* b_kv_norm; const float* b_w_uq; const float* b_w_ukv; const float* c_sink; const float* d_lambda; const float* d_sub_norm;
    const float* w_out; const float* norm2; const float* w_ff1; const float* w_ff2; const float* rel_bias; const float* final_norm;
    float* out; unsigned char* ws;
};

__device__ __forceinline__ int perm128(int p) { const int half = p >> 6, w = p & 63; return half * 64 + (w >> 1) + 32 * (w & 1); }
__device__ __forceinline__ int perm64(int p) { return (p >> 1) + 32 * (p & 1); }
template <int MAP> __device__ __forceinline__ int srcmap(int nd, float& sc) {
    sc = 1.f;
    if (MAP == 0) return nd;
    if (MAP == 1) {
        if (nd >= INC) return -1;
        if (nd < C_AV) return (nd & ~127) + perm128(nd & 127);
        if (nd >= C_BKR && nd < C_CQ) return C_BKR + perm64(nd - C_BKR);
        if (nd >= C_CQ && nd < C_CK) sc = SC_A;
        if (nd >= C_DQ && nd < C_DK) sc = SC_D;
        return nd;
    }
    sc = SC_B; const int hd = nd / 192, p = nd % 192;
    return p < 128 ? nd : hd * 192 + 128 + perm64(p - 128);
}
template <int MAP>
__device__ __forceinline__ void transpose_item(const float* W, int K, int N, int Npad, bf16_t* WT, const float* gk, LAS float* scr, int item, int lane) {
    const int nblk = Npad / 32, kb = item / nblk, nb = item % nblk, k0 = 64 * kb, n0 = 32 * nb;
    float sc; const int ns = srcmap<MAP>(n0 + (lane & 31), sc);
    float wv[32];
    const float* Wp = W + (size_t)(k0 + (lane >> 5)) * N + (ns >= 0 ? ns : 0);
#pragma unroll
    for (int i = 0; i < 32; ++i) wv[i] = Wp[(size_t)(2 * i) * N];
#pragma unroll
    for (int i = 0; i < 32; ++i) { const int kk = 2 * i + (lane >> 5); float v = ns >= 0 ? wv[i] : 0.f; if (gk) v *= gk[k0 + kk]; scr[kk * 33 + (lane & 31)] = v * sc; }
    asm volatile("s_waitcnt lgkmcnt(0)" ::: "memory");
    const int c = lane & 7;
#pragma unroll
    for (int j = 0; j < 4; ++j) { const int n = (lane >> 3) + 8 * j; const LAS float* s = scr + (8 * c) * 33 + n;
        u32x4 o; o.x = pk2(s[0 * 33], s[1 * 33]); o.y = pk2(s[2 * 33], s[3 * 33]); o.z = pk2(s[4 * 33], s[5 * 33]); o.w = pk2(s[6 * 33], s[7 * 33]);
        *(u32x4*)(WT + (size_t)(n0 + n) * K + k0 + 8 * c) = o; }
    asm volatile("s_waitcnt lgkmcnt(0)" ::: "memory");
}
__device__ __forceinline__ int t5_bucket(int rel) {
    const int n = rel < 0 ? -rel : rel;
    int b = n < 8 ? n : min(15, 2 + (31 - __clz(n * n)));
    return b + (rel > 0 ? 16 : 0);
}

template <bool FINAL>
__device__ __forceinline__ void norm_pass(const float* X, const float* g, const float* scale, const float* shift, bf16_t* H, float* OUTF, int vcu_, int NGW_, int wave_s) {
    int vcu = vcu_, NGW = NGW_; asm volatile("" : "+s"(vcu), "+s"(NGW));
    int tid_ = tid_of(wave_s);
    const int lane = tid_ & 63, gw = vcu * NWAVES + wave_s;
    f32x4 gm[8], sh[8];
#pragma unroll
    for (int j = 0; j < 8; ++j) { const f32x4 gv = ((const f32x4*)g)[64 * j + lane];
        if (!FINAL) { const f32x4 s = ((const f32x4*)scale)[64 * j + lane]; gm[j] = gv * (1.f + s); sh[j] = ((const f32x4*)shift)[64 * j + lane]; } else { gm[j] = gv; sh[j] = (f32x4){0.f, 0.f, 0.f, 0.f}; } }
    f32x4 nv[8];
    { const f32x4* xr = (const f32x4*)(X + (size_t)gw * DM) + lane;
#pragma unroll
        for (int j = 0; j < 8; ++j) nv[j] = xr[64 * j]; }
    for (int m = gw; m < SEQ; m += NGW) {
        f32x4 v[8]; float ss = 0.f;
#pragma unroll
        for (int j = 0; j < 8; ++j) v[j] = nv[j];
        if (m + NGW < SEQ) { const f32x4* xn = (const f32x4*)(X + (size_t)(m + NGW) * DM) + lane;
#pragma unroll
            for (int j = 0; j < 8; ++j) nv[j] = xn[64 * j]; }
#pragma unroll
        for (int j = 0; j < 8; ++j) ss += (v[j].x * v[j].x + v[j].y * v[j].y) + (v[j].z * v[j].z + v[j].w * v[j].w);
        const float rstd = 1.0f / sqrtf(wave_sum(ss) * (1.f / DM) + EPS);
        if (FINAL) { f32x4* orow = (f32x4*)(OUTF + (size_t)m * DM) + lane;
#pragma unroll
            for (int j = 0; j < 8; ++j) orow[64 * j] = v[j] * rstd * gm[j]; }
        else { u32x2* orow = (u32x2*)(H + (size_t)m * DM) + lane;
#pragma unroll
            for (int j = 0; j < 8; ++j) { const f32x4 y = v[j] * rstd * gm[j] + sh[j]; u32x2 w; w.x = pk2(y.x, y.y); w.y = pk2(y.z, y.w); orow[64 * j] = w; } }
    }
}


__device__ __forceinline__ void store_o_tile(const f32x16 (&o)[4], char* lds, bf16_t* Og, int wave_s) {
    int tid_ = tid_of(wave_s);
    const int wid = tid_ >> 6, lane = tid_ & 63, r32 = lane & 31, hi = lane >> 5;
    __syncthreads();
    bf16_t* stg = (bf16_t*)(lds + wid * 8192);
#pragma unroll
    for (int r = 0; r < 16; ++r) { const int orow = att::crow(r, hi);
#pragma unroll
        for (int d0 = 0; d0 < 4; ++d0) stg[orow * 128 + d0 * 32 + r32] = (bf16_t)f2bf(o[d0][r]); }
    asm volatile("s_waitcnt lgkmcnt(0)" ::: "memory");
#pragma unroll
    for (int i = 0; i < 8; ++i) { const int row = i * 4 + (lane >> 4), ch = lane & 15; const u32x4 v = *(const u32x4*)(stg + row * 128 + ch * 8); *(u32x4*)(Og + (size_t)row * DM + ch * 8) = v;
        if (i & 1) asm volatile("" ::: "memory"); }
    asm volatile("s_waitcnt lgkmcnt(0)" ::: "memory");
}

__global__ void __launch_bounds__(NTHR, 2) mega_fwd(Args a) {
    extern __shared__ __attribute__((aligned(16))) unsigned char lds[];
    cg::grid_group grid = cg::this_grid();
    const int wave_s = __builtin_amdgcn_readfirstlane((int)threadIdx.x >> 6);
    const int tid = tid_of(wave_s), lane = tid & 63, wave = wave_s;
    const int G = gridDim.x, bx = blockIdx.x;
    const int vcu = (G % 8 == 0) ? (bx % 8) * (G / 8) + bx / 8 : bx;
    const int gw = vcu * NWAVES + wave, NGW = G * NWAVES;
#define PH unsigned char* ws = a.ws; asm volatile("" : "+s"(ws)); int lq = l; asm volatile("" : "+s"(lq)); (void)lq;
#define LAM ((float*)(ws + WS_CTL))
#define SMV ((float*)(ws + WS_SMALL))
#define MOD ((float*)(ws + WS_MOD))
#define TAB ((f32x2*)(ws + WS_TAB))
#define RS ((float*)(ws + WS_RS))
#define WIN ((bf16_t*)(ws + WS_WIN))
#define WUQ ((bf16_t*)(ws + WS_WUQ))
#define WUKV ((bf16_t*)(ws + WS_WUKV))
#define WOUT ((bf16_t*)(ws + WS_WOUT))
#define WFF1 ((bf16_t*)(ws + WS_WFF1))
#define WFF2 ((bf16_t*)(ws + WS_WFF2))
#define H ((bf16_t*)(ws + WS_H))
#define DSCR ((float*)(ws + WS_DSCR))
#define P ((bf16_t*)(ws + WS_P))
#define QB ((bf16_t*)(ws + WS_QB))
#define KVB ((bf16_t*)(ws + WS_KVB))
#define O ((bf16_t*)(ws + WS_O))
#define HID ((bf16_t*)(ws + WS_HID))
    LAS unsigned char* ldsl = (LAS unsigned char*)lds;

    {
        const int l = 0; PH
        LAS float* scr = (LAS float*)(ldsl + wave * 16384);
        constexpr int I_IN = (DM / 64) * (INP / 32), I_UQ = (384 / 64) * (768 / 32), I_UKV = (256 / 64) * (1024 / 32), I_OUT = (DM / 64) * (DM / 32), I_F1 = (DM / 64) * (DFF / 32), I_F2 = (DFF / 64) * (DM / 32);
        constexpr int I_L = I_IN + I_UQ + I_UKV + I_OUT + I_F1 + I_F2;
        for (int it = gw; it < NLAYER * I_L; it += NGW) {
            const int l = it / I_L; int r = it % I_L;
            if (r < I_IN) { transpose_item<1>(a.w_in + (size_t)l * DM * INC, DM, INC, INP, WIN + (size_t)l * INP * DM, nullptr, scr, r, lane); continue; } r -= I_IN;
            if (r < I_UQ) { transpose_item<2>(a.b_w_uq + (size_t)l * 384 * 768, 384, 768, 768, WUQ + (size_t)l * 768 * 384, a.b_q_norm + l * 384, scr, r, lane); continue; } r -= I_UQ;
            if (r < I_UKV) { transpose_item<0>(a.b_w_ukv + (size_t)l * 256 * 1024, 256, 1024, 1024, WUKV + (size_t)l * 1024 * 256, a.b_kv_norm + l * 256, scr, r, lane); continue; } r -= I_UKV;
            if (r < I_OUT) { transpose_item<0>(a.w_out + (size_t)l * DM * DM, DM, DM, DM, WOUT + (size_t)l * DM * DM, nullptr, scr, r, lane); continue; } r -= I_OUT;
            if (r < I_F1) { transpose_item<0>(a.w_ff1 + (size_t)l * DM * DFF, DM, DFF, DFF, WFF1 + (size_t)l * DFF * DM, nullptr, scr, r, lane); continue; } r -= I_F1;
            transpose_item<0>(a.w_ff2 + (size_t)l * DFF * DM, DFF, DM, DM, WFF2 + (size_t)l * DM * DFF, nullptr, scr, r, lane);
        }
        for (int e = bx * NTHR + tid; e < SEQ * 32; e += G * NTHR) {
            const int pos = e >> 5, i = e & 31;
            const float inv = (float)exp2(-(double)i * (13.287712379549449 / 32.0));
            const float ang = (float)pos * inv;
            const double rev = (double)ang * 0.15915494309189535; const float fr = (float)(rev - rint(rev));
            TAB[e] = (f32x2){__builtin_amdgcn_cosf(fr), __builtin_amdgcn_sinf(fr)};
        }
        if (bx == 0) { float* sm = SMV;
            for (int i = tid; i < 4096; i += NTHR) { sm[SM_N1 + i] = a.norm1[i]; sm[SM_N2 + i] = a.norm2[i]; }
            for (int i = tid; i < 2048; i += NTHR) sm[SM_FN + i] = a.final_norm[i];
            if (tid < 256) { sm[SM_AQ + tid] = a.a_q_norm[tid]; sm[SM_AK + tid] = a.a_k_norm[tid]; sm[SM_DS + tid] = a.d_sub_norm[tid]; sm[SM_RB + tid] = a.rel_bias[tid]; }
            if (tid < 8) sm[SM_CS + tid] = a.c_sink[tid]; }
        if (bx == 0) for (int i = tid; i < XCD_BAR_WORDS; i += NTHR) ((unsigned*)(ws + WS_BAR))[i] = 0u;
        if (tid < 4) ((LAS unsigned*)(ldsl + MISC_OFF))[tid] = 0u;
        if (bx == 0 && wave == 0) {
            for (int l = 0; l < NLAYER; ++l) { const float* lf = a.d_lambda + l * 256;
                const float sa = wave_sum(lf[lane] * lf[64 + lane]), sb = wave_sum(lf[128 + lane] * lf[192 + lane]);
                const float lam_init = 0.8f - 0.6f * expf(-0.3f * (float)l);
                if (lane == 0) LAM[l] = expf(sa) - expf(sb) + lam_init; }
        }
        __syncthreads();
        LAS float* red = (LAS float*)ldsl;
        for (int ch = bx; ch < NLAYER * 192; ch += G) {
            const int l = ch / 192, n0 = (ch % 192) * 64; const float* W = a.w_ada + (size_t)l * DM * 12288;
            const int cg4 = lane & 15, ksub = lane >> 4; f32x4 acc = {0.f, 0.f, 0.f, 0.f};
#pragma unroll 16
            for (int kk = 0; kk < 64; ++kk) { const int k = wave * 256 + kk * 4 + ksub; const float cv = a.c[k]; const float sv = cv / (1.f + expf(-cv));
                const f32x4 w = *(const f32x4*)(W + (size_t)k * 12288 + n0 + cg4 * 4); acc += w * sv; }
#pragma unroll
            for (int e = 0; e < 4; ++e) { acc[e] += swz_xor<16>(acc[e]); auto rr = __builtin_amdgcn_permlane32_swap(__float_as_uint(acc[e]), __float_as_uint(acc[e]), false, false); acc[e] = __uint_as_float(rr[0]) + __uint_as_float(rr[1]); }
            if (ksub == 0) { red[wave * 64 + cg4 * 4 + 0] = acc[0]; red[wave * 64 + cg4 * 4 + 1] = acc[1]; red[wave * 64 + cg4 * 4 + 2] = acc[2]; red[wave * 64 + cg4 * 4 + 3] = acc[3]; }
            __syncthreads();
            if (tid < 64) { float s = 0.f;
#pragma unroll
                for (int w = 0; w < 8; ++w) s += red[w * 64 + tid];
                MOD[l * 12288 + n0 + tid] = s + a.b_ada[l * 12288 + n0 + tid]; }
            __syncthreads();
        }
    }
    grid.sync();
    (void)xcd_barrier_post((unsigned*)(a.ws + WS_BAR), (volatile LAS unsigned*)(ldsl + MISC_OFF), tid_of(wave_s) == 0);
#define GRID_BAR() do { unsigned char* wsb = a.ws; asm volatile("" : "+s"(wsb)); XcdBarrier xb_; xb_.bar = (unsigned*)(wsb + WS_BAR); xb_.x = xb_xcc_id(); xb_.st = (volatile LAS unsigned*)(ldsl + MISC_OFF); xcd_barrier(xb_, wave_s); } while (0)

    for (int l = 0; l < NLAYER; ++l) {
        const int tid = tid_of(wave_s), lane = tid & 63, wave = wave_s, gw = vcu * NWAVES + wave;
        { PH const float* mod = MOD + lq * 12288; norm_pass<false>((lq == 0) ? a.x : a.out, SMV + SM_N1 + lq * DM, mod + 1 * DM, mod + 0 * DM, H, nullptr, vcu, NGW, wave_s); }
        GRID_BAR();
        { PH pg8::Gemm g{H, WIN + (size_t)lq * INP * DM, SEQ, INP, DM, DM}; pg8::StaticOrder S; S.init(SEQ, INP, G, bx);
          pg8::EpiBf16<0> E{P, INP, nullptr, nullptr}; pg8::gemm_phase(ldsl, g, S, E, wave_s); }
        GRID_BAR();
        { PH
            const float* gq = SMV + SM_AQ + lq * 128; const float* gk = SMV + SM_AK + lq * 128;
            const int p0i = perm128(2 * lane), p1i = perm128(2 * lane + 1);
            const float gq0 = gq[p0i], gq1 = gq[p1i], gk0 = gk[p0i], gk1 = gk[p1i];
            for (int t = gw; t < SEQ; t += NGW) {
                bf16_t* row = P + (size_t)t * INP;
                unsigned w[12];
#pragma unroll
                for (int hd = 0; hd < 6; ++hd) w[hd] = ((const unsigned*)(row + hd * 128))[lane];
                w[6] = ((const unsigned*)(row + C_BKR))[lane & 31];
#pragma unroll
                for (int j = 0; j < 3; ++j) w[7 + j] = ((const unsigned*)(row + C_BCQ))[lane + 64 * j];
#pragma unroll
                for (int j = 0; j < 2; ++j) w[10 + j] = ((const unsigned*)(row + C_BCKV))[lane + 64 * j];
                const int pos = lane < 32 ? (t >> 6) : (t & 63); const f32x2 cs = TAB[pos * 32 + (lane & 31)], c2 = TAB[t * 32 + (lane & 31)];
#pragma unroll
                for (int hd = 0; hd < 6; ++hd) {
                    float x0 = bf2f((unsigned short)(w[hd] & 0xffff)), x1 = bf2f((unsigned short)(w[hd] >> 16));
                    const float rstd = 1.0f / sqrtf(wave_sum(x0 * x0 + x1 * x1) * (1.f / 128.f) + EPS);
                    const float qs = hd < 4 ? SC_A : 1.f;
                    x0 *= rstd * (hd < 4 ? gq0 : gk0) * qs; x1 *= rstd * (hd < 4 ? gq1 : gk1) * qs;
                    ((unsigned*)(row + hd * 128))[lane] = pk2(x0 * cs.x - x1 * cs.y, x1 * cs.x + x0 * cs.y); }
                if (lane < 32) { const float x0 = bf2f((unsigned short)(w[6] & 0xffff)), x1 = bf2f((unsigned short)(w[6] >> 16));
                    ((unsigned*)(row + C_BKR))[lane] = pk2(x0 * c2.x - x1 * c2.y, x1 * c2.x + x0 * c2.y); }
                float sq = 0.f, skv = 0.f;
#pragma unroll
                for (int j = 0; j < 3; ++j) { const float x0 = bf2f((unsigned short)(w[7 + j] & 0xffff)), x1 = bf2f((unsigned short)(w[7 + j] >> 16)); sq += x0 * x0 + x1 * x1; }
#pragma unroll
                for (int j = 0; j < 2; ++j) { const float x0 = bf2f((unsigned short)(w[10 + j] & 0xffff)), x1 = bf2f((unsigned short)(w[10 + j] >> 16)); skv += x0 * x0 + x1 * x1; }
                sq = wave_sum(sq); skv = wave_sum(skv);
                if (lane == 0) { RS[t] = 1.0f / sqrtf(sq * (1.f / 384.f) + EPS); RS[SEQ + t] = 1.0f / sqrtf(skv * (1.f / 256.f) + EPS); }
            }
        }
        GRID_BAR();
        { PH pg8::Gemm g{P + C_BCQ, WUQ + (size_t)lq * 768 * 384, SEQ, 768, 384, INP}; pg8::StaticOrder S; S.init(SEQ, 768, G, bx);
          pg8::EpiBf16<3> E{QB, 768, RS, TAB}; pg8::gemm_phase(ldsl, g, S, E, wave_s); }
        { PH pg8::Gemm g{P + C_BCKV, WUKV + (size_t)lq * 1024 * 256, SEQ, 1024, 256, INP}; pg8::StaticOrder S; S.init(SEQ, 1024, G, bx);
          pg8::EpiBf16<2> E{KVB, 1024, RS + SEQ, nullptr}; pg8::gemm_phase(ldsl, g, S, E, wave_s); }
        GRID_BAR();
        for (int u = vcu; u < 256; u += G) { PH
            const int hd = u >> 6, blk = u & 63, q0 = blk * 256;
            f32x16 o[4];
#define UNIT_IDS int tidu = tid_of(wave_s); const int wid = tidu >> 6, lane = tidu & 63, r32 = lane & 31, tid = tidu; (void)r32; (void)tid;
            float* lut = (float*)(lds + att::OFF_LUT);
            { UNIT_IDS att::attn_core<8, 0>(P + (size_t)q0 * INP + C_AQ + hd * 128, INP, P + C_AK + (hd >> 1) * 128, INP, nullptr, 0, P + C_AV + (hd >> 1) * 128, INP, 0, SEQ / 64, q0, nullptr, 0.f, 0.f, 0.f, 0.f, (char*)lds, o, wave_s);
              store_o_tile(o, (char*)lds, O + (size_t)(q0 + wid * 32) * DM + (0 + hd) * 128, wave_s); }
            { UNIT_IDS att::attn_core<12, 0>(QB + (size_t)q0 * 768 + hd * 192, 768, KVB + hd * 256, 1024, P + C_BKR, INP, KVB + hd * 256 + 128, 1024, 0, SEQ / 64, q0, nullptr, 0.f, 0.f, 0.f, 0.f, (char*)lds, o, wave_s);
              store_o_tile(o, (char*)lds, O + (size_t)(q0 + wid * 32) * DM + (4 + hd) * 128, wave_s); }
            { UNIT_IDS __syncthreads();
              if (tid < 257) lut[tid] = SMV[SM_RB + t5_bucket(tid - 128) * 8 + hd] * LOG2E;
              const int ks = q0 - 128 < 0 ? 0 : q0 - 128, ke = q0 + 384 > SEQ ? SEQ : q0 + 384;
              const float sink = SMV[SM_CS + lq * 4 + hd] * LOG2E;
              att::attn_core<8, 2>(P + (size_t)q0 * INP + C_CQ + hd * 128, INP, P + C_CK + (hd >> 1) * 128, INP, nullptr, 0, P + C_CV + (hd >> 1) * 128, INP, ks / 64, (ke - ks) / 64, q0, lut, 0.f, 0.f, sink, 1.f, (char*)lds, o, wave_s);
              store_o_tile(o, (char*)lds, O + (size_t)(q0 + wid * 32) * DM + (8 + hd) * 128, wave_s); }
            { UNIT_IDS __syncthreads();
              if (tid < 257) lut[tid] = SMV[SM_RB + t5_bucket(tid - 128) * 8 + 4 + hd] * LOG2E;
              const float cbL = SMV[SM_RB + 15 * 8 + 4 + hd] * LOG2E, cbR = SMV[SM_RB + 31 * 8 + 4 + hd] * LOG2E;
              att::attn_core<4, 1>(P + (size_t)q0 * INP + C_DQ + hd * 128, INP, P + C_DK + hd * 128, INP, nullptr, 0, P + C_DV + hd * 128, INP, 0, SEQ / 64, q0, lut, cbL, cbR, 0.f, 0.f, (char*)lds, o, wave_s);
              { float* scrp = DSCR + ((size_t)(u * 8 + wave_s) * 64) * 64 + (tid_of(wave_s) & 63);
#pragma unroll
              for (int d0 = 0; d0 < 4; ++d0)
#pragma unroll
                  for (int r = 0; r < 16; ++r) scrp[(d0 * 16 + r) * 64] = o[d0][r]; }
              att::attn_core<4, 1>(P + (size_t)q0 * INP + C_DQ + hd * 128 + 64, INP, P + C_DK + hd * 128 + 64, INP, nullptr, 0, P + C_DV + hd * 128, INP, 0, SEQ / 64, q0, lut, cbL, cbR, 0.f, 0.f, (char*)lds, o, wave_s);
              const int lane2 = tid_of(wave_s) & 63, r32b = lane2 & 31;
              const float* scrq = DSCR + ((size_t)(u * 8 + wave_s) * 64) * 64 + lane2; asm volatile("" : "+v"(scrq) :: "memory");
              const float lam = LAM[lq]; const float* gs = SMV + SM_DS + lq * 128; const float post = 1.f - (0.8f - 0.6f * expf(-0.3f * (float)lq));
              float gv[4];
#pragma unroll
              for (int d0 = 0; d0 < 4; ++d0) gv[d0] = gs[d0 * 32 + r32b] * post;
#pragma unroll
              for (int r = 0; r < 16; ++r) { float ss = 0.f;
#pragma unroll
                  for (int d0 = 0; d0 < 4; ++d0) { const float dv = scrq[(d0 * 16 + r) * 64] - lam * o[d0][r]; o[d0][r] = dv; ss += dv * dv; }
                  ss = half_sum(ss);
                  const float rstd = 1.0f / sqrtf(ss * (1.f / 128.f) + EPS);
#pragma unroll
                  for (int d0 = 0; d0 < 4; ++d0) o[d0][r] *= rstd * gv[d0];
                  if ((r & 3) == 3) asm volatile("" ::: "memory"); }
              store_o_tile(o, (char*)lds, O + (size_t)(q0 + wid * 32) * DM + (12 + hd) * 128, wave_s); }
        }
        GRID_BAR();
        { PH pg8::Gemm g{O, WOUT + (size_t)lq * DM * DM, SEQ, DM, DM, DM}; pg8::StaticOrder S; S.init(SEQ, DM, G, bx);
          pg8::EpiRes E{(lq == 0) ? a.x : a.out, a.out, MOD + lq * 12288 + 2 * DM, DM}; pg8::gemm_phase(ldsl, g, S, E, wave_s); }
        GRID_BAR();
        { PH const float* mod = MOD + lq * 12288; norm_pass<false>(a.out, SMV + SM_N2 + lq * DM, mod + 4 * DM, mod + 3 * DM, H, nullptr, vcu, NGW, wave_s); }
        GRID_BAR();
        { PH pg8::Gemm g{H, WFF1 + (size_t)lq * DFF * DM, SEQ, DFF, DM, DM}; pg8::StaticOrder S; S.init(SEQ, DFF, G, bx);
          pg8::EpiBf16<1> E{HID, DFF, nullptr, nullptr}; pg8::gemm_phase(ldsl, g, S, E, wave_s); }
        GRID_BAR();
        { PH pg8::Gemm g{HID, WFF2 + (size_t)lq * DM * DFF, SEQ, DM, DFF, DFF}; pg8::StaticOrder S; S.init(SEQ, DM, G, bx);
          pg8::EpiRes E{a.out, a.out, MOD + lq * 12288 + 5 * DM, DM}; pg8::gemm_phase(ldsl, g, S, E, wave_s); }
        GRID_BAR();
    }
    { const int l = 0; PH norm_pass<true>(a.out, SMV + SM_FN, nullptr, nullptr, nullptr, a.out, vcu, NGW, wave_s); }
}

extern "C" void kernel_launch(void* const* d_in, const int* in_sizes, int n_in, void* d_out, int out_size, void* d_ws, size_t ws_size, hipStream_t stream) {
    static int grid = 0;
    if (grid == 0) {
        if (n_in != 21 || out_size != SEQ * DM || ws_size < WS_END) { fprintf(stderr, "kernel_launch: unexpected shapes (n_in %d out %d ws %zu)\n", n_in, out_size, ws_size); grid = -1; return; }
        int dev = 0, cus = 0, per_cu = 0;
        hipGetDevice(&dev); hipDeviceGetAttribute(&cus, hipDeviceAttributeMultiprocessorCount, dev);
        if (hipFuncSetAttribute((const void*)mega_fwd, hipFuncAttributeMaxDynamicSharedMemorySize, LDS_BYTES) != hipSuccess) { fprintf(stderr, "kernel_launch: hipFuncSetAttribute failed\n"); grid = -1; return; }
        if (hipOccupancyMaxActiveBlocksPerMultiprocessor(&per_cu, (const void*)mega_fwd, NTHR, LDS_BYTES) != hipSuccess || per_cu < 1) { fprintf(stderr, "kernel_launch: occupancy query gave %d\n", per_cu); per_cu = 1; }
        (void)hipGetLastError();
        grid = cus * 1;
    }
    if (grid < 0) return;
    Args a{};
    const float** f = (const float**)&a;
    for (int i = 0; i < 21; ++i) f[i] = (const float*)d_in[i];
    a.out = (float*)d_out; a.ws = (unsigned char*)d_ws;
    void* args[] = {&a};
    hipError_t e = hipLaunchCooperativeKernel((const void*)mega_fwd, dim3(grid), dim3(NTHR), args, LDS_BYTES, stream);
    if (e != hipSuccess) fprintf(stderr, "cooperative launch failed: %s (grid %d)\n", hipGetErrorString(e), grid);
}
```

```cpp
#include <hip/hip_runtime.h>
#include <hip/hip_bf16.h>
#include <hip/hip_cooperative_groups.h>
#include <cstdio>
#include <cstdint>
namespace cg = cooperative_groups;

#define LAS __attribute__((address_space(3)))
typedef unsigned short bf16_t;
typedef short bf16x8 __attribute__((ext_vector_type(8)));
typedef short s16x4 __attribute__((ext_vector_type(4)));
typedef float f32x4 __attribute__((ext_vector_type(4)));
typedef float f32x2 __attribute__((ext_vector_type(2)));
typedef float f32x16 __attribute__((ext_vector_type(16)));
typedef unsigned u32x4 __attribute__((ext_vector_type(4)));
typedef unsigned u32x2 __attribute__((ext_vector_type(2)));

constexpr int SEQ = 16384, DM = 2048, DFF = 8192, INC = 4288, INP = 4352, NLAYER = 2;
constexpr int C_AQ = 0, C_AK = 512, C_AV = 768, C_BCQ = 1024, C_BCKV = 1408, C_BKR = 1664, C_CQ = 1728, C_CK = 2240, C_CV = 2496, C_DQ = 2752, C_DK = 3264, C_DV = 3776;
constexpr float LOG2E = 1.4426950408889634f;
constexpr float SC_A = 0.08838834764831845f * LOG2E;
constexpr float SC_B = 0.07216878364870323f * LOG2E;
constexpr float SC_D = 0.125f * LOG2E;
constexpr float EPS = 1e-6f;

constexpr size_t MiB = 1u << 20;
constexpr size_t WS_CTL = 0;
constexpr size_t WS_SMALL = 131072;
constexpr int SM_N1 = 0, SM_N2 = 4096, SM_FN = 8192, SM_AQ = 10240, SM_AK = 10496, SM_DS = 10752, SM_CS = 11008, SM_RB = 11024, SM_END = 11280;
constexpr size_t WS_BAR = 65536;
constexpr size_t WS_MOD = 1 * MiB;
constexpr size_t WS_TAB = 2 * MiB;
constexpr size_t WS_RS = 6 * MiB;
constexpr size_t WS_WIN = 8 * MiB;
constexpr size_t WS_WUQ = 42 * MiB;
constexpr size_t WS_WUKV = 44 * MiB;
constexpr size_t WS_WOUT = 46 * MiB;
constexpr size_t WS_WFF1 = 62 * MiB;
constexpr size_t WS_WFF2 = 126 * MiB;
constexpr size_t WS_H = 190 * MiB;
constexpr size_t WS_DSCR = 254 * MiB;
constexpr size_t WS_P = 288 * MiB;
constexpr size_t WS_QB = 424 * MiB;
constexpr size_t WS_KVB = 448 * MiB;
constexpr size_t WS_O = 480 * MiB;
constexpr size_t WS_HID = 288 * MiB;
constexpr size_t WS_END = 544 * MiB;

__device__ __forceinline__ int tid_of(int wave_s) { int l; asm volatile("v_mbcnt_lo_u32_b32 %0, -1, 0\n\tv_mbcnt_hi_u32_b32 %0, -1, %0" : "=v"(l)); return wave_s * 64 + l; }
__device__ __forceinline__ unsigned f2bf(float f) { unsigned u = __builtin_bit_cast(unsigned, f); return (u + 0x7fffu + ((u >> 16) & 1u)) >> 16; }
__device__ __forceinline__ unsigned pk2(float lo, float hi) { return f2bf(lo) | (f2bf(hi) << 16); }
__device__ __forceinline__ float bf2f(unsigned short b) { return __builtin_bit_cast(float, (unsigned)b << 16); }
__device__ __forceinline__ unsigned cvtpk(float lo, float hi) { unsigned r; asm volatile("v_cvt_pk_bf16_f32 %0, %1, %2" : "=v"(r) : "v"(lo), "v"(hi)); return r; }
template <int X> __device__ __forceinline__ float swz_xor(float v) { return __builtin_bit_cast(float, __builtin_amdgcn_ds_swizzle(__builtin_bit_cast(int, v), 0x1f | (X << 10))); }
__device__ __forceinline__ float half_sum(float v) {
    v += swz_xor<1>(v); v += swz_xor<2>(v); v += swz_xor<4>(v); v += swz_xor<8>(v); v += swz_xor<16>(v); return v;
}
__device__ __forceinline__ float wave_sum(float v) {
    v = half_sum(v);
    auto rr = __builtin_amdgcn_permlane32_swap(__float_as_uint(v), __float_as_uint(v), false, false);
    return __uint_as_float(rr[0]) + __uint_as_float(rr[1]);
}

namespace pg8 {
constexpr int BM = 256, BK = 64, HALF = 128, HTB = HALF * BK * 2, STAGE_BYTES = 8 * HTB, NXCD = 8, WGM = 8;
__host__ __device__ __forceinline__ int lds_byte(int r, int c) { const int st = (r >> 4) * 2 + (c >> 5), rr = r & 15, cc = c & 31, ob = rr * 64 + cc * 2; return st * 1024 + (ob ^ (((ob >> 9) & 1) << 5)); }
__host__ __device__ __forceinline__ void stage_rc(int b, int& R, int& C) { const int st = b / 1024, sb = b % 1024, swz = sb ^ (((sb >> 9) & 1) << 5); R = (st >> 1) * 16 + swz / 64; C = (st & 1) * 32 + (swz % 64) / 2; }
__host__ __device__ __forceinline__ int perm32(int rho) { const int n = rho >> 4, i = rho & 15; return 8 * (i >> 2) + 4 * n + (i & 3); }
struct Unit { int pm, pn; };
struct Gemm { const bf16_t* A; const bf16_t* Bt; int M, N, K, lda; };
struct StaticOrder {
    int nM, nN, nwg, G, c;
    __host__ __device__ void init(int M, int N, int G_, int c_) { nM = M / BM; nN = N / BM; nwg = nM * nN; G = G_; c = c_; }
    __host__ __device__ bool next(int i, Unit& u) const {
        const long L = (long)i * G + c; if (L >= nwg) return false;
        int wgid = (int)L; { const int q = nwg / NXCD, r = nwg % NXCD, xcd = wgid % NXCD, off = wgid / NXCD; wgid = (xcd < r ? xcd * (q + 1) : r * (q + 1) + (xcd - r) * q) + off; }
        const int nig = WGM * nN, gid = wgid / nig, fm = gid * WGM, gsz = (nM - fm) < WGM ? (nM - fm) : WGM;
        u.pm = fm + ((wgid % nig) % gsz); u.pn = (wgid % nig) / gsz; return true;
    }
};
template <int MODE> struct EpiBf16 {
    static constexpr bool PERM = true;
    bf16_t* O; int ldc; const float* rs; const f32x2* tab;
    __device__ __forceinline__ void operator()(const f32x4 (&acc)[2][2][4][2], const Unit& u, int wr, int wc, int fr, int fq) const {
        const int row0 = u.pm * BM + wr * 64 + fr; const int col0 = u.pn * BM + wc * 32 + 8 * fq;
        bool rot[2]; int i0[2];
#pragma unroll
        for (int bj = 0; bj < 2; ++bj) { const int cm = (col0 + bj * HALF) % 192; rot[bj] = (MODE == 3) && cm >= 128; i0[bj] = rot[bj] ? (cm - 128) >> 1 : 0; }
#pragma unroll
        for (int am = 0; am < 4; ++am) { const int ai = am >> 1;
            f32x4 t0[4][2], t1[4][2]; float rsv[2][4];
#pragma unroll
            for (int m = 2 * (am & 1); m < 2 * (am & 1) + 2; ++m) rsv[ai][m] = (MODE >= 2) ? rs[row0 + ai * HALF + m * 16] : 1.f;
            if (MODE == 3) {
#pragma unroll
                for (int m = 2 * (am & 1); m < 2 * (am & 1) + 2; ++m)
#pragma unroll
                    for (int bj = 0; bj < 2; ++bj) { const f32x4* tp = (const f32x4*)(tab + (size_t)(row0 + ai * HALF + m * 16) * 32 + i0[bj]); t0[m][bj] = tp[0]; t1[m][bj] = tp[1];
                        if (!rot[bj]) { t0[m][bj] = (f32x4){1.f, 0.f, 1.f, 0.f}; t1[m][bj] = t0[m][bj]; } }
                asm volatile("" ::: "memory");
            }
#pragma unroll
            for (int m = 2 * (am & 1); m < 2 * (am & 1) + 2; ++m) { const int row = row0 + ai * HALF + m * 16; bf16_t* rowp = O + (size_t)row * ldc + col0;
                const float rsvv = rsv[ai][m];
#pragma unroll
                for (int bj = 0; bj < 2; ++bj) { f32x4 v0 = acc[ai][bj][m][0], v1 = acc[ai][bj][m][1];
                    if (MODE == 1) {
#pragma unroll
                        for (int e = 0; e < 4; ++e) { float a = fmaxf(v0[e], 0.f), b = fmaxf(v1[e], 0.f); v0[e] = a * a; v1[e] = b * b; } }
                    if (MODE >= 2) { v0 = v0 * rsvv; v1 = v1 * rsvv; }
                    if (MODE == 3) { const f32x4 a0 = t0[m][bj], a1 = t1[m][bj]; f32x4 w0, w1;
                        w0[0] = v0[0] * a0[0] - v0[1] * a0[1]; w0[1] = v0[1] * a0[0] + v0[0] * a0[1]; w0[2] = v0[2] * a0[2] - v0[3] * a0[3]; w0[3] = v0[3] * a0[2] + v0[2] * a0[3];
                        w1[0] = v1[0] * a1[0] - v1[1] * a1[1]; w1[1] = v1[1] * a1[0] + v1[0] * a1[1]; w1[2] = v1[2] * a1[2] - v1[3] * a1[3]; w1[3] = v1[3] * a1[2] + v1[2] * a1[3];
                        v0 = w0; v1 = w1; }
                    u32x4 w; w.x = cvtpk(v0[0], v0[1]); w.y = cvtpk(v0[2], v0[3]); w.z = cvtpk(v1[0], v1[1]); w.w = cvtpk(v1[2], v1[3]);
                    *(u32x4*)(rowp + bj * HALF) = w; } }
            if (MODE >= 2) asm volatile("" ::: "memory");
        }
    }
};
struct EpiRes {
    static constexpr bool PERM = false;
    const float* res; float* out; const float* gate; int ldc;
    __device__ __forceinline__ void operator()(const f32x4 (&acc)[2][2][4][2], const Unit& u, int wr, int wc, int fr, int fq) const {
        const int col0 = u.pn * BM + wc * 32 + 4 * fq;
        f32x4 gv[2][2];
#pragma unroll
        for (int bj = 0; bj < 2; ++bj)
#pragma unroll
            for (int n = 0; n < 2; ++n) gv[bj][n] = *(const f32x4*)(gate + col0 + bj * HALF + n * 16);
#pragma unroll
        for (int ai = 0; ai < 2; ++ai) {
            f32x4 bs[4][2][2];
#pragma unroll
            for (int m = 0; m < 4; ++m) { const size_t off = (size_t)(u.pm * BM + ai * HALF + wr * 64 + m * 16 + fr) * ldc + col0;
#pragma unroll
                for (int bj = 0; bj < 2; ++bj)
#pragma unroll
                    for (int n = 0; n < 2; ++n) bs[m][bj][n] = *(const f32x4*)(res + off + bj * HALF + n * 16); }
            asm volatile("" ::: "memory");
#pragma unroll
            for (int m = 0; m < 4; ++m) { const size_t off = (size_t)(u.pm * BM + ai * HALF + wr * 64 + m * 16 + fr) * ldc + col0;
#pragma unroll
                for (int bj = 0; bj < 2; ++bj)
#pragma unroll
                    for (int n = 0; n < 2; ++n) *(f32x4*)(out + off + bj * HALF + n * 16) = bs[m][bj][n] + gv[bj][n] * acc[ai][bj][m][n]; }
            asm volatile("" ::: "memory");
        }
    }
};

template <class Epi>
__device__ __forceinline__ void gemm_phase(LAS unsigned char* lds, const Gemm g, const StaticOrder& S, const Epi& E, int wave_s) {
    int tid_ = tid_of(wave_s);
    const int tid = tid_, wid = __builtin_amdgcn_readfirstlane(tid >> 6), lane = tid & 63, wr = wid >> 2, wc = wid & 3, fr = lane & 15, fq = lane >> 4;
    const int K = g.K, nt = K / BK;
    unsigned voffA[2], voffB[2];
#pragma unroll
    for (int i = 0; i < 2; ++i) { int R, C; stage_rc(tid * 16 + i * 8192, R, C); const int Rb = Epi::PERM ? ((R & ~31) + perm32(R & 31)) : R;
        voffA[i] = (unsigned)(R * g.lda + C) * 2u; voffB[i] = (unsigned)(Rb * K + C) * 2u; }
    const size_t kstep = (size_t)(BK * 2);
    const size_t hstepA = (size_t)HALF * g.lda * 2, hstepB = (size_t)HALF * K * 2;
    const size_t tstepA = 2 * hstepA, tstepB = 2 * hstepB;
    const unsigned ldsw = (unsigned)wid * 1024u;
    const int aoff = lds_byte(wr * 64 + fr, fq * 8), boff = lds_byte(wc * 32 + fr, fq * 8);
#define PG8_SA(b, h) (((b) * 2 + (h)) * HTB)
#define PG8_SB(b, h) ((4 + (b) * 2 + (h)) * HTB)
#define PG8_STAGE(bufoff, gbase, voff) do { _Pragma("unroll") for (int _i = 0; _i < 2; ++_i) \
        __builtin_amdgcn_global_load_lds((const unsigned*)((const char*)(gbase) + (voff)[_i]), (LAS unsigned*)(lds + (bufoff) + ldsw + _i * 8192), 16, 0, 0); } while (0)
#define PG8_LDA(dst, b, h) do { _Pragma("unroll") for (int m = 0; m < 4; ++m) _Pragma("unroll") for (int k = 0; k < 2; ++k) dst[m][k] = *(const LAS bf16x8*)(lds + PG8_SA(b, h) + aoff + m * 2048 + k * 1024); } while (0)
#define PG8_LDB(dst, b, h) do { _Pragma("unroll") for (int n = 0; n < 2; ++n) _Pragma("unroll") for (int k = 0; k < 2; ++k) dst[n][k] = *(const LAS bf16x8*)(lds + PG8_SB(b, h) + boff + n * 2048 + k * 1024); } while (0)
#define PG8_MMA(ai, bj, At, Bt) do { __builtin_amdgcn_s_setprio(1); _Pragma("unroll") for (int m = 0; m < 4; ++m) _Pragma("unroll") for (int n = 0; n < 2; ++n) _Pragma("unroll") for (int k = 0; k < 2; ++k) \
        acc[ai][bj][m][n] = __builtin_amdgcn_mfma_f32_16x16x32_bf16(Bt[n][k], At[m][k], acc[ai][bj][m][n], 0, 0, 0); __builtin_amdgcn_s_setprio(0); } while (0)
#define PG8_WAIT_V(n) asm volatile("s_waitcnt vmcnt(" #n ")" ::: "memory")
#define PG8_WAIT_L(n) asm volatile("s_waitcnt lgkmcnt(" #n ")" ::: "memory")
#define PG8_BAR __builtin_amdgcn_s_barrier()
#define PG8_SCHED __builtin_amdgcn_sched_barrier(0)
    Unit cur, nxt; int ui = 0;
    if (!S.next(0, cur)) return;
    f32x4 acc[2][2][4][2];
#pragma unroll
    for (int a = 0; a < 2; ++a)
#pragma unroll
        for (int b = 0; b < 2; ++b)
#pragma unroll
            for (int m = 0; m < 4; ++m)
#pragma unroll
                for (int n = 0; n < 2; ++n) acc[a][b][m][n] = (f32x4){0.f, 0.f, 0.f, 0.f};
    bf16x8 At[4][2], B0[2][2], B1[2][2];
    const char* cA = (const char*)g.A + (size_t)cur.pm * tstepA; const char* cB = (const char*)g.Bt + (size_t)cur.pn * tstepB;
    PG8_STAGE(PG8_SB(0, 0), cB, voffB); PG8_STAGE(PG8_SB(0, 1), cB + hstepB, voffB); PG8_STAGE(PG8_SA(0, 0), cA, voffA); PG8_STAGE(PG8_SA(0, 1), cA + hstepA, voffA);
    if (wr == 1) PG8_BAR;
    PG8_WAIT_V(2); PG8_BAR;
    PG8_STAGE(PG8_SB(1, 0), cB + kstep, voffB); PG8_STAGE(PG8_SA(1, 0), cA + kstep, voffA); PG8_STAGE(PG8_SB(1, 1), cB + hstepB + kstep, voffB);
    PG8_WAIT_V(6); PG8_BAR;
    for (;;) {
        const bool has_next = S.next(ui + 1, nxt);
        const char* nA = has_next ? (const char*)g.A + (size_t)nxt.pm * tstepA : cA; const char* nB = has_next ? (const char*)g.Bt + (size_t)nxt.pn * tstepB : cB;
        for (int t = 0; t < nt; t += 2) {
            const bool last = (t == nt - 2);
            const char* a1 = cA + (size_t)(t + 1) * kstep;
            const char* a2 = last ? nA : cA + (size_t)(t + 2) * kstep; const char* b2 = last ? nB : cB + (size_t)(t + 2) * kstep;
            const char* a3 = a2 + kstep; const char* b3 = b2 + kstep;
            PG8_LDB(B0, 0, 0); PG8_LDB(B1, 0, 1); PG8_SCHED; PG8_LDA(At, 0, 0); PG8_STAGE(PG8_SA(1, 1), a1 + hstepA, voffA);
            PG8_WAIT_V(8); PG8_WAIT_L(0); PG8_BAR; PG8_MMA(0, 0, At, B0); PG8_MMA(0, 1, At, B1); PG8_BAR; PG8_SCHED;
            PG8_LDA(At, 0, 1); PG8_STAGE(PG8_SB(0, 0), b2, voffB); PG8_STAGE(PG8_SB(0, 1), b2 + hstepB, voffB); PG8_STAGE(PG8_SA(0, 0), a2, voffA);
            PG8_WAIT_V(8); PG8_WAIT_L(0); PG8_BAR; PG8_MMA(1, 0, At, B0); PG8_MMA(1, 1, At, B1); PG8_BAR; PG8_SCHED;
            PG8_LDB(B0, 1, 0); PG8_LDB(B1, 1, 1); PG8_SCHED; PG8_LDA(At, 1, 0); PG8_STAGE(PG8_SA(0, 1), a2 + hstepA, voffA);
            PG8_WAIT_V(8); PG8_WAIT_L(0); PG8_BAR; PG8_MMA(0, 0, At, B0); PG8_MMA(0, 1, At, B1); PG8_BAR; PG8_SCHED;
            PG8_LDA(At, 1, 1); PG8_STAGE(PG8_SB(1, 0), b3, voffB); PG8_STAGE(PG8_SB(1, 1), b3 + hstepB, voffB); PG8_STAGE(PG8_SA(1, 0), a3, voffA);
            PG8_WAIT_V(8); PG8_WAIT_L(0); PG8_BAR; PG8_MMA(1, 0, At, B0); PG8_MMA(1, 1, At, B1); PG8_BAR; PG8_SCHED;
        }
        if (wr == 0) PG8_BAR;
        { const int l2_ = tid_of(wave_s) & 63; E(acc, cur, wr, wc, l2_ & 15, l2_ >> 4); }
        if (!has_next) break;
#pragma unroll
        for (int a = 0; a < 2; ++a)
#pragma unroll
            for (int b = 0; b < 2; ++b)
#pragma unroll
                for (int m = 0; m < 4; ++m)
#pragma unroll
                    for (int n = 0; n < 2; ++n) acc[a][b][m][n] = (f32x4){0.f, 0.f, 0.f, 0.f};
        cur = nxt; cA = nA; cB = nB; ++ui;
        if (wr == 1) PG8_BAR;
    }
    PG8_WAIT_V(0);
    PG8_BAR;
#undef PG8_SA
#undef PG8_SB
#undef PG8_STAGE
#undef PG8_LDA
#undef PG8_LDB
#undef PG8_MMA
#undef PG8_WAIT_V
#undef PG8_WAIT_L
#undef PG8_BAR
#undef PG8_SCHED
}
}

namespace att {
constexpr int NW = 8, QBLK = 32, KVBLK = 64;
constexpr int SHM_V = KVBLK * 128 * 2;
constexpr int SHM_KMAX = KVBLK * 384;
constexpr int OFF_K = 0, OFF_V = 3 * SHM_KMAX, OFF_WS = OFF_V + 4 * SHM_V, OFF_LUT = OFF_WS + NW * 256, ATT_LDS = OFF_LUT + 2048;
constexpr float THR2 = 11.5f;
#define SBAR() __builtin_amdgcn_sched_barrier(0)
__device__ __forceinline__ int crow(int r, int hi) { return (r & 3) + 8 * (r >> 2) + 4 * hi; }
__device__ __forceinline__ int v_st(int k, int c) { const int kk = (k & ~0xC) | ((k & 4) << 1) | ((k & 8) >> 1); return ((kk >> 3) * 4 + (c >> 5)) * 512 + ((kk & 7) * 32 + (c & 31)) * 2; }
__device__ __forceinline__ int v_rd_base(int lane) { return ((lane & 3) << 3) | (((lane >> 2) & 3) << 6) | (((lane >> 4) & 1) << 5) | (((lane >> 5) & 1) << 8); }
constexpr int v_rd_off(int d0, int ks, int half) { return d0 * 512 + ks * 4096 + half * 2048; }
template <int OFF> __device__ __forceinline__ s16x4 tr_read(int vb) {
    s16x4 r; asm volatile("ds_read_b64_tr_b16 %0, %1 offset:%2" : "=&v"(r) : "v"(vb), "i"(OFF) : "memory"); return r;
}
template <int D0> __device__ __forceinline__ void pv_one(f32x16& od, int vb, bf16x8 pa0, bf16x8 pa1, bf16x8 pa2, bf16x8 pa3) {
    const s16x4 l0 = tr_read<v_rd_off(D0, 0, 0)>(vb), h0 = tr_read<v_rd_off(D0, 0, 1)>(vb), l1 = tr_read<v_rd_off(D0, 1, 0)>(vb), h1 = tr_read<v_rd_off(D0, 1, 1)>(vb);
    const s16x4 l2 = tr_read<v_rd_off(D0, 2, 0)>(vb), h2 = tr_read<v_rd_off(D0, 2, 1)>(vb), l3 = tr_read<v_rd_off(D0, 3, 0)>(vb), h3 = tr_read<v_rd_off(D0, 3, 1)>(vb);
    asm volatile("s_waitcnt lgkmcnt(0)" ::: "memory"); SBAR();
#define PK(L, H) (bf16x8){L[0], L[1], L[2], L[3], H[0], H[1], H[2], H[3]}
    od = __builtin_amdgcn_mfma_f32_32x32x16_bf16(pa0, PK(l0, h0), od, 0, 0, 0);
    od = __builtin_amdgcn_mfma_f32_32x32x16_bf16(pa1, PK(l1, h1), od, 0, 0, 0);
    od = __builtin_amdgcn_mfma_f32_32x32x16_bf16(pa2, PK(l2, h2), od, 0, 0, 0);
    od = __builtin_amdgcn_mfma_f32_32x32x16_bf16(pa3, PK(l3, h3), od, 0, 0, 0);
#undef PK
}
template <bool RSM> __device__ __forceinline__ void pv_d0(f32x16* o, f32x16& lacc, int vb, bf16x8 pa0, bf16x8 pa1, bf16x8 pa2, bf16x8 pa3) {
    if (RSM) {
        const bf16x8 ones = {0x3F80, 0x3F80, 0x3F80, 0x3F80, 0x3F80, 0x3F80, 0x3F80, 0x3F80};
        lacc = __builtin_amdgcn_mfma_f32_32x32x16_bf16(pa0, ones, lacc, 0, 0, 0);
        lacc = __builtin_amdgcn_mfma_f32_32x32x16_bf16(pa1, ones, lacc, 0, 0, 0);
        lacc = __builtin_amdgcn_mfma_f32_32x32x16_bf16(pa2, ones, lacc, 0, 0, 0);
        lacc = __builtin_amdgcn_mfma_f32_32x32x16_bf16(pa3, ones, lacc, 0, 0, 0); }
    pv_one<0>(o[0], vb, pa0, pa1, pa2, pa3); pv_one<1>(o[1], vb, pa0, pa1, pa2, pa3); pv_one<2>(o[2], vb, pa0, pa1, pa2, pa3); pv_one<3>(o[3], vb, pa0, pa1, pa2, pa3);
}
template <int MODE, bool FIRST, bool FOLD>
__device__ __forceinline__ bool partialSM(f32x16& p0, f32x16& p1, float& m_reg, float& alpha, int relbase, bool near, const float* lut, float cb) {
    if (!FOLD) { const float off_ = cb - m_reg;
#pragma unroll
        for (int r = 0; r < 16; ++r) { p0[r] += off_; p1[r] += off_; } }
    if (MODE != 0 && near) {
#pragma unroll
        for (int r = 0; r < 16; ++r) { const int rel = relbase + (r & 3) + 8 * (r >> 2), rel1 = rel + 32;
            const int i0 = min(max(rel, -128), 128) + 128, i1 = min(max(rel1, -128), 128) + 128;
            const float b0 = lut[i0], b1 = lut[i1];
            if (MODE == 1) { p0[r] += b0; p1[r] += b1; }
            else { p0[r] = (rel >= -128 && rel <= 128) ? p0[r] + b0 : -1e30f; p1[r] = (rel1 >= -128 && rel1 <= 128) ? p1[r] + b1 : -1e30f; } }
    }
    float pmax = p0[0];
#pragma unroll
    for (int r = 1; r < 16; ++r) pmax = fmaxf(pmax, p0[r]);
#pragma unroll
    for (int r = 0; r < 16; ++r) pmax = fmaxf(pmax, p1[r]);
    { auto rr = __builtin_amdgcn_permlane32_swap(__float_as_uint(pmax), __float_as_uint(pmax), false, false);
      pmax = fmaxf(__uint_as_float(rr[0]), __uint_as_float(rr[1])); }
    bool resc;
    if (FIRST && MODE != 2) resc = true; else resc = __any(pmax > THR2);
    if (__builtin_expect(resc, FIRST && MODE != 2)) {
        const float delta = (FIRST && MODE != 2) ? pmax : fmaxf(pmax, 0.f);
        m_reg += delta; alpha = (FIRST && MODE != 2) ? 1.f : __builtin_amdgcn_exp2f(-delta);
#pragma unroll
        for (int r = 0; r < 16; ++r) { p0[r] -= delta; p1[r] -= delta; }
    } else alpha = 1.f;
#pragma unroll
    for (int r = 0; r < 16; ++r) p0[r] = __builtin_amdgcn_exp2f(p0[r]);
    return resc;
}
template <bool RSM> __device__ __forceinline__ void finishSM(f32x16& p0, f32x16& p1, float& l_reg, bf16x8& pa0, bf16x8& pa1, bf16x8& pa2, bf16x8& pa3) {
#pragma unroll
    for (int r = 0; r < 16; ++r) p1[r] = __builtin_amdgcn_exp2f(p1[r]);
    float ps = 0;
    if (!RSM) {
#pragma unroll
    for (int r = 0; r < 16; ++r) ps += p0[r];
#pragma unroll
    for (int r = 0; r < 16; ++r) ps += p1[r];
    { auto rr = __builtin_amdgcn_permlane32_swap(__float_as_uint(ps), __float_as_uint(ps), false, false);
      ps = __uint_as_float(rr[0]) + __uint_as_float(rr[1]); }
    l_reg += ps; }
#define PK4(P, BASE, OUT) do { u32x4 w = {cvtpk(P[BASE + 0], P[BASE + 1]), cvtpk(P[BASE + 2], P[BASE + 3]), cvtpk(P[BASE + 4], P[BASE + 5]), cvtpk(P[BASE + 6], P[BASE + 7])}; \
    OUT = *reinterpret_cast<bf16x8*>(&w); } while (0)
    PK4(p0, 0, pa0); PK4(p0, 8, pa1); PK4(p1, 0, pa2); PK4(p1, 8, pa3);
#undef PK4
}
template <int OFF> __device__ __forceinline__ bf16x8 lds_rd128(int addr) {
    bf16x8 r; asm volatile("ds_read_b128 %0, %1 offset:%2" : "=&v"(r) : "v"(addr), "i"(OFF) : "memory"); return r;
}
#define PK4X(P, BASE, OUT) do { u32x4 w = {cvtpk(P[BASE + 0], P[BASE + 1]), cvtpk(P[BASE + 2], P[BASE + 3]), cvtpk(P[BASE + 4], P[BASE + 5]), cvtpk(P[BASE + 6], P[BASE + 7])}; \
    OUT = *reinterpret_cast<bf16x8*>(&w); } while (0)
template <int S, bool RSM> __device__ __forceinline__ void fsm_step(f32x16& pc0, f32x16& pc1, float& ps, float& l_reg, bf16x8& pa0, bf16x8& pa1, bf16x8& pa2, bf16x8& pa3) {
    if (S < 4) {
#pragma unroll
        for (int r = 0; r < 4; ++r) pc1[4 * S + r] = __builtin_amdgcn_exp2f(pc1[4 * S + r]); }
    if (S == 4) { PK4X(pc0, 0, pa0); if (!RSM) ps = ((pc0[0] + pc0[1]) + (pc0[2] + pc0[3])) + ((pc0[4] + pc0[5]) + (pc0[6] + pc0[7])); }
    if (S == 5) { PK4X(pc0, 8, pa1); if (!RSM) ps += ((pc0[8] + pc0[9]) + (pc0[10] + pc0[11])) + ((pc0[12] + pc0[13]) + (pc0[14] + pc0[15])); }
    if (S == 6) { PK4X(pc1, 0, pa2); if (!RSM) ps += ((pc1[0] + pc1[1]) + (pc1[2] + pc1[3])) + ((pc1[4] + pc1[5]) + (pc1[6] + pc1[7])); }
    if (S == 7 && RSM) PK4X(pc1, 8, pa3);
    if (S == 7 && !RSM) { PK4X(pc1, 8, pa3); ps += ((pc1[8] + pc1[9]) + (pc1[10] + pc1[11])) + ((pc1[12] + pc1[13]) + (pc1[14] + pc1[15]));
        auto rr = __builtin_amdgcn_permlane32_swap(__float_as_uint(ps), __float_as_uint(ps), false, false); l_reg += __uint_as_float(rr[0]) + __uint_as_float(rr[1]); }
}
template <int NQ, int I> __device__ __forceinline__ void krd_pair(bf16x8& f0, bf16x8& f1, int ka, const int (&kb1)[2], const int (&kb2)[2]) {
    constexpr bool HAS1 = NQ >= 8; constexpr int SHM_K1 = HAS1 ? 16384 : 0, NP1 = HAS1 ? 8 : 0;
    if (I < NP1) { const int a_ = ka + kb1[0] + (((I < 8 ? I : 0) ^ kb1[1]) << 5); f0 = lds_rd128<0>(a_); f1 = lds_rd128<8192>(a_); }
    else { const int a_ = ka + kb2[0] + ((((I - NP1) & 3) ^ kb2[1]) << 5); f0 = lds_rd128<SHM_K1>(a_); f1 = lds_rd128<SHM_K1 + 4096>(a_); }
}
template <int NQ, int I> __device__ __forceinline__ void qk_slot(f32x16& pn0, f32x16& pn1, f32x16& pc0, f32x16& pc1, float& ps, float& l_reg, bf16x8& pa0, bf16x8& pa1, bf16x8& pa2, bf16x8& pa3,
                                                                   bf16x8 (&kf0)[3], bf16x8 (&kf1)[3], int ka, const int (&kb1)[2], const int (&kb2)[2], const bf16x8* qr, const f32x16& cinit) {
    constexpr int AH = 1, RING = AH + 1;
    if (I + AH < NQ) krd_pair<NQ, (I + AH < NQ ? I + AH : 0)>(kf0[(I + AH) % RING], kf1[(I + AH) % RING], ka, kb1, kb2);
    constexpr int LEFT = (NQ - 1 - I) < AH ? (NQ - 1 - I) : AH;
    if (LEFT == 2) asm volatile("s_waitcnt lgkmcnt(4)" ::: "memory"); else if (LEFT == 1) asm volatile("s_waitcnt lgkmcnt(2)" ::: "memory"); else asm volatile("s_waitcnt lgkmcnt(0)" ::: "memory");
    SBAR();
    if (I == 0) { pn0 = __builtin_amdgcn_mfma_f32_32x32x16_bf16(kf0[0], qr[0], cinit, 0, 0, 0); pn1 = __builtin_amdgcn_mfma_f32_32x32x16_bf16(kf1[0], qr[0], cinit, 0, 0, 0); }
    else { pn0 = __builtin_amdgcn_mfma_f32_32x32x16_bf16(kf0[I % RING], qr[I], pn0, 0, 0, 0); pn1 = __builtin_amdgcn_mfma_f32_32x32x16_bf16(kf1[I % RING], qr[I], pn1, 0, 0, 0); }
    if (NQ == 4) { fsm_step<2 * I, (NQ == 4)>(pc0, pc1, ps, l_reg, pa0, pa1, pa2, pa3); fsm_step<2 * I + 1, (NQ == 4)>(pc0, pc1, ps, l_reg, pa0, pa1, pa2, pa3); }
    else if (I < 8) fsm_step<(I < 8 ? I : 0), (NQ == 4)>(pc0, pc1, ps, l_reg, pa0, pa1, pa2, pa3);
    SBAR();
}
template <int NQ>
__device__ __forceinline__ void qk_fsm(f32x16& pn0, f32x16& pn1, f32x16& pc0, f32x16& pc1, float& l_reg, bf16x8& pa0, bf16x8& pa1, bf16x8& pa2, bf16x8& pa3,
                                       int ka, const int (&kb1)[2], const int (&kb2)[2], const bf16x8* qr, const f32x16& cinit, bf16x8 kfp0, bf16x8 kfp1) {
    bf16x8 kf0[3], kf1[3]; float ps = 0.f;
    if (NQ != 12) {
        kf0[0] = kfp0; kf1[0] = kfp1;
        asm volatile("" : "+v"(kf0[0]), "+v"(kf1[0]));
    }
    asm volatile("s_waitcnt lgkmcnt(0)" ::: "memory"); SBAR();
    if (NQ == 12) krd_pair<NQ, 0>(kf0[0], kf1[0], ka, kb1, kb2);
    qk_slot<NQ, 0>(pn0, pn1, pc0, pc1, ps, l_reg, pa0, pa1, pa2, pa3, kf0, kf1, ka, kb1, kb2, qr, cinit);
    qk_slot<NQ, 1>(pn0, pn1, pc0, pc1, ps, l_reg, pa0, pa1, pa2, pa3, kf0, kf1, ka, kb1, kb2, qr, cinit);
    qk_slot<NQ, 2>(pn0, pn1, pc0, pc1, ps, l_reg, pa0, pa1, pa2, pa3, kf0, kf1, ka, kb1, kb2, qr, cinit);
    qk_slot<NQ, 3>(pn0, pn1, pc0, pc1, ps, l_reg, pa0, pa1, pa2, pa3, kf0, kf1, ka, kb1, kb2, qr, cinit);
    if (NQ >= 8) {
        qk_slot<NQ, 4>(pn0, pn1, pc0, pc1, ps, l_reg, pa0, pa1, pa2, pa3, kf0, kf1, ka, kb1, kb2, qr, cinit);
        qk_slot<NQ, 5>(pn0, pn1, pc0, pc1, ps, l_reg, pa0, pa1, pa2, pa3, kf0, kf1, ka, kb1, kb2, qr, cinit);
        qk_slot<NQ, 6>(pn0, pn1, pc0, pc1, ps, l_reg, pa0, pa1, pa2, pa3, kf0, kf1, ka, kb1, kb2, qr, cinit);
        qk_slot<NQ, 7>(pn0, pn1, pc0, pc1, ps, l_reg, pa0, pa1, pa2, pa3, kf0, kf1, ka, kb1, kb2, qr, cinit); }
    if (NQ == 12) {
        qk_slot<NQ, 8>(pn0, pn1, pc0, pc1, ps, l_reg, pa0, pa1, pa2, pa3, kf0, kf1, ka, kb1, kb2, qr, cinit);
        qk_slot<NQ, 9>(pn0, pn1, pc0, pc1, ps, l_reg, pa0, pa1, pa2, pa3, kf0, kf1, ka, kb1, kb2, qr, cinit);
        qk_slot<NQ, 10>(pn0, pn1, pc0, pc1, ps, l_reg, pa0, pa1, pa2, pa3, kf0, kf1, ka, kb1, kb2, qr, cinit);
        qk_slot<NQ, 11>(pn0, pn1, pc0, pc1, ps, l_reg, pa0, pa1, pa2, pa3, kf0, kf1, ka, kb1, kb2, qr, cinit); }
}
template <int NQ>
__device__ __forceinline__ void qkt(f32x16& p0, f32x16& p1, const char* Ks, const int (&kq1)[2], const int (&kq2)[2], const bf16x8* qr, const f32x16& cinit) {
    int kb1[8], kb2[4];
#pragma unroll
    for (int i = 0; i < 8; ++i) kb1[i] = kq1[0] + ((i ^ kq1[1]) << 5);
#pragma unroll
    for (int i = 0; i < 4; ++i) kb2[i] = kq2[0] + ((i ^ kq2[1]) << 5);
    constexpr bool HAS1 = NQ >= 8, HAS2 = NQ != 8; constexpr int SHM_K1 = HAS1 ? 16384 : 0;
    p0 = cinit; p1 = cinit;
    if (HAS1) {
#pragma unroll
        for (int d0 = 0; d0 < 8; ++d0) { const char* a = Ks + kb1[d0];
            const bf16x8 b0 = *reinterpret_cast<const bf16x8*>(a); const bf16x8 b1 = *reinterpret_cast<const bf16x8*>(a + 8192);
            p0 = __builtin_amdgcn_mfma_f32_32x32x16_bf16(b0, qr[d0], p0, 0, 0, 0);
            p1 = __builtin_amdgcn_mfma_f32_32x32x16_bf16(b1, qr[d0], p1, 0, 0, 0); } }
    if (HAS2) {
#pragma unroll
        for (int d = 0; d < 4; ++d) { const char* a = Ks + SHM_K1 + kb2[d];
            const bf16x8 b0 = *reinterpret_cast<const bf16x8*>(a); const bf16x8 b1 = *reinterpret_cast<const bf16x8*>(a + 4096);
            p0 = __builtin_amdgcn_mfma_f32_32x32x16_bf16(b0, qr[(NQ == 12 ? 8 : 0) + d], p0, 0, 0, 0);
            p1 = __builtin_amdgcn_mfma_f32_32x32x16_bf16(b1, qr[(NQ == 12 ? 8 : 0) + d], p1, 0, 0, 0); } }
}
template <int NQ, int MODE>
__device__ __forceinline__ void attn_core(const bf16_t* __restrict__ Qb, int ldq, const bf16_t* __restrict__ K0, int ldk0, const bf16_t* __restrict__ K1, int ldk1,
                                          const bf16_t* __restrict__ Vh, int ldv, int kt0, int NT, int q0, const float* lut, float cbL, float cbR, float m_init, float l_init,
                                          char* lds, f32x16 (&o)[4], int wave_s) {
    constexpr bool HAS1 = NQ >= 8, HAS2 = NQ != 8;
    constexpr int SHM_K1 = HAS1 ? 16384 : 0, SHM_K2 = HAS2 ? 8192 : 0, SHM_KT = SHM_K1 + SHM_K2;
    constexpr int NLK = (HAS1 ? 2 : 0) + (HAS2 ? 1 : 0), NLV = 2, NL = NLK + NLV;
    constexpr bool FOLD = (NQ != 12 && MODE != 2);
    int tid_ = tid_of(wave_s);
    const int tid = tid_, wid = wave_s, lane = tid & 63, r32 = lane & 31, hi = lane >> 5;
    char* K_lds = lds + OFF_K; char* V_lds = lds + OFF_V;
    float* ws = (float*)(lds + OFF_WS) + wid * 64; float* li_l = ws; float* al_l = ws + 32;
    constexpr bool RSM = (NQ == 4);
    float m_reg = m_init, l_reg = l_init;
    f32x16 lacc;
#pragma unroll
    for (int r = 0; r < 16; ++r) lacc[r] = l_init;
#pragma unroll
    for (int d = 0; d < 4; ++d) o[d] = f32x16{};
    const int ldk2 = (NQ == 4) ? ldk0 : ldk1; const bf16_t* K2 = (NQ == 4) ? K0 : K1;
    unsigned voK1[2], voK2, voV[2];
#pragma unroll
    for (int i = 0; i < 2; ++i) { const int p = wid + 8 * i, row = 4 * p + (lane >> 4), cbs = (lane & 15) ^ (row & 15); voK1[i] = (unsigned)(row * ldk0 + cbs * 8) * 2u; }
    { const int row = 8 * wid + (lane >> 3), cbs = (lane & 7) ^ ((row >> 1) & 7); voK2 = (unsigned)(row * ldk2 + cbs * 8) * 2u; }
#pragma unroll
    for (int i = 0; i < 2; ++i) { const int p = wid + 8 * i, sub = 2 * p + (lane >> 5), kk = ((sub >> 2) << 3) | ((lane & 31) >> 2);
        const int k = kk, c = (sub & 3) * 32 + (lane & 3) * 8; voV[i] = (unsigned)(k * ldv + c) * 2u; }
    const char* gK1 = (const char*)(K0 + (size_t)kt0 * KVBLK * ldk0); const size_t stK1 = (size_t)KVBLK * ldk0 * 2;
    const char* gK2 = (const char*)(K2 + (size_t)kt0 * KVBLK * ldk2); const size_t stK2 = (size_t)KVBLK * ldk2 * 2;
    const char* gV = (const char*)(Vh + (size_t)kt0 * KVBLK * ldv); const size_t stV = (size_t)KVBLK * ldv * 2;
    LAS unsigned char* K3 = (LAS unsigned char*)K_lds; LAS unsigned char* V3 = (LAS unsigned char*)V_lds;
#define GLDS(g, l) __builtin_amdgcn_global_load_lds((const unsigned*)(g), (LAS unsigned*)(l), 16, 0, 0)
    const char* pK1a = gK1 + voK1[0]; const char* pK1b = gK1 + voK1[1]; const char* pK2p = gK2 + voK2; const char* pVa = gV + voV[0]; const char* pVb = gV + voV[1];
#define DMA_K(t, st) do { if (HAS1) { GLDS(pK1a, K3 + (st) * SHM_KT + wid * 1024); GLDS(pK1b, K3 + (st) * SHM_KT + (wid + 8) * 1024); pK1a += stK1; pK1b += stK1; } \
    if (HAS2) { GLDS(pK2p, K3 + (st) * SHM_KT + SHM_K1 + wid * 1024); pK2p += stK2; } } while (0)
#define DMA_V(t, st) do { GLDS(pVa, V3 + (st) * SHM_V + wid * 1024); GLDS(pVb, V3 + (st) * SHM_V + (wid + 8) * 1024); pVa += stV; pVb += stV; } while (0)
#define WAIT_BAR(N) asm volatile("s_waitcnt vmcnt(" #N ") lgkmcnt(0)\n\ts_barrier" ::: "memory")
#define WAITB(n) do { if ((n) == 0) WAIT_BAR(0); else if ((n) == 1) WAIT_BAR(1); else if ((n) == 2) WAIT_BAR(2); else if ((n) == 3) WAIT_BAR(3); else if ((n) == 4) WAIT_BAR(4); else WAIT_BAR(5); } while (0)
    bf16x8 qr[NQ];
    const bf16_t* Qw = Qb + (long)(wid * QBLK + r32) * ldq + hi * 8;
    __syncthreads();
#pragma unroll
    for (int d0 = 0; d0 < NQ; ++d0) qr[d0] = *reinterpret_cast<const bf16x8*>(Qw + d0 * 16);
    DMA_K(0, 0); DMA_V(0, 0); DMA_K(1, 1);
    const int lo1 = (hi ^ (r32 & 1)) << 4, s3 = (r32 >> 1) & 7, b1_ = r32 * 256 + lo1;
    const int kb1[2] = {b1_, s3};
    const int lo2 = (hi ^ ((r32 >> 1) & 1)) << 4, s2 = (r32 >> 2) & 3, b2_ = r32 * 128 + lo2;
    const int kb2[2] = {b2_, s2};
    const int vb0 = (int)(uintptr_t)V_lds + v_rd_base(lane);
    const int kl0 = (int)(uintptr_t)K_lds;
    const int qw = q0 + wid * QBLK;
#define RESC(a, rs) do { if (__builtin_expect((rs), 0)) { if (hi == 0) al_l[r32] = (a); asm volatile("s_waitcnt lgkmcnt(0)" ::: "memory"); \
    _Pragma("unroll") for (int r = 0; r < 16; ++r) { const float al_ = al_l[crow(r, hi)]; if (RSM) lacc[r] *= al_; _Pragma("unroll") for (int d = 0; d < 4; ++d) o[d][r] *= al_; } } l_reg *= (a); } while (0)
#define TILEP(t) const int k0t = (kt0 + (t)) * KVBLK; const int relb = k0t - qw - r32 + 4 * hi; \
    const bool nearT = (MODE == 2) ? true : ((MODE == 1) ? !(k0t + 154 <= qw || k0t >= qw + 122) : false); \
    const float cbT = (MODE == 1 && !nearT) ? (k0t < qw ? cbL : cbR) : 0.f;
    f32x16 cinit = f32x16{}; float cur_cb = 0.f; bool dirty = true;
#define CINIT(t) do { TILEP(t); (void)relb; if (FOLD && __builtin_expect(dirty || cbT != cur_cb, 0)) { const float v_ = cbT - m_reg; _Pragma("unroll") for (int r = 0; r < 16; ++r) cinit[r] = v_; asm volatile("" : "+v"(cinit)); cur_cb = cbT; dirty = false; } } while (0)
    f32x16 pA0, pA1, pB0, pB1; float alA, alB; bool rsA, rsB; bf16x8 pa0, pa1, pa2, pa3;
    WAITB(NLK);
    if (2 < NT) DMA_K(2, 2); DMA_V(1, 1);
    CINIT(0);
    qkt<NQ>(pA0, pA1, K_lds, kb1, kb2, qr, cinit); { TILEP(0); (void)cbT; rsA = partialSM<MODE, true, FOLD>(pA0, pA1, m_reg, alA, relb, nearT, lut, cbT); dirty |= rsA; }
    l_reg *= alA;
    if (2 < NT) WAITB(NL); else WAITB(NLV);
#define grp1 (wid >= 4)
    int kc = 1, vp = 0;
#define KST(x) ((x) >= 3 ? (x) - 3 : (x))
#define VST(x) ((x) >= 4 ? (x) - 4 : (x))
    bf16x8 kfp0 = {}, kfp1 = {};
#define KPRE(st) do { if (NQ == 12) break; const char* kp_ = K_lds + (st) * SHM_KT; if (HAS1) { const int a_ = kb1[0] + (kb1[1] << 5); kfp0 = *reinterpret_cast<const bf16x8*>(kp_ + a_); kfp1 = *reinterpret_cast<const bf16x8*>(kp_ + a_ + 8192); } \
    else { const int a_ = kb2[0] + (kb2[1] << 5); kfp0 = *reinterpret_cast<const bf16x8*>(kp_ + a_); kfp1 = *reinterpret_cast<const bf16x8*>(kp_ + a_ + 4096); } SBAR(); } while (0)
#define EVENT(jj) do { if (__builtin_expect((jj) + 3 < NT, 1)) { WAITB(NL); DMA_K((jj) + 3, kc); DMA_V((jj) + 2, VST(vp + 3)); }     \
    else if ((jj) + 3 == NT) { WAITB(NL); DMA_V((jj) + 2, VST(vp + 3)); } else { WAITB(NLV); } } while (0)
#define STEP(C0, C1, P0, P1, alC, rsC, jj) do { \
    SBAR(); qk_fsm<NQ>(C0, C1, P0, P1, l_reg, pa0, pa1, pa2, pa3, kl0 + kc * SHM_KT, kb1, kb2, qr, cinit, kfp0, kfp1); SBAR(); \
    if (grp1) EVENT(jj); \
    pv_d0<RSM>(o, lacc, vb0 + vp * SHM_V, pa0, pa1, pa2, pa3); \
    if (!grp1) EVENT(jj); \
    kc = KST(kc + 1); vp = VST(vp + 1); \
    KPRE(kc); \
    { TILEP(jj); (void)cbT; rsC = partialSM<MODE, false, FOLD>(C0, C1, m_reg, alC, relb, nearT, lut, cbT); dirty |= rsC; } \
    RESC(alC, rsC); CINIT((jj) + 1); } while (0)
    DMA_K(3, 0); DMA_V(2, 2);
    KPRE(kc); CINIT(1);
    for (int j = 1; j + 1 < NT; j += 2) {
        STEP(pB0, pB1, pA0, pA1, alB, rsB, j);
        STEP(pA0, pA1, pB0, pB1, alA, rsA, j + 1);
    }
    SBAR(); qk_fsm<NQ>(pB0, pB1, pA0, pA1, l_reg, pa0, pa1, pa2, pa3, kl0 + kc * SHM_KT, kb1, kb2, qr, cinit, kfp0, kfp1); SBAR();
    if (grp1) WAITB(0);
    pv_d0<RSM>(o, lacc, vb0 + vp * SHM_V, pa0, pa1, pa2, pa3);
    if (!grp1) WAITB(0);
    { TILEP(NT - 1); (void)cbT; rsB = partialSM<MODE, false, FOLD>(pB0, pB1, m_reg, alB, relb, nearT, lut, cbT); }
    RESC(alB, rsB);
    finishSM<RSM>(pB0, pB1, l_reg, pa0, pa1, pa2, pa3); SBAR();
    pv_d0<RSM>(o, lacc, vb0 + VST(vp + 1) * SHM_V, pa0, pa1, pa2, pa3);
    (void)alA;
    if (hi == 0) li_l[r32] = l_reg; asm volatile("s_waitcnt lgkmcnt(0)" ::: "memory");
#pragma unroll
    for (int r = 0; r < 16; ++r) { const float rl = __builtin_amdgcn_rcpf(RSM ? lacc[r] : li_l[crow(r, hi)]);
#pragma unroll
        for (int d = 0; d < 4; ++d) o[d][r] *= rl; }
#undef GLDS
#undef DMA_K
#undef DMA_V
#undef WAIT_BAR
#undef WAITB
#undef RESC
#undef TILEP
#undef CINIT
#undef KPRE
#undef EVENT
#undef STEP
#undef grp1
#undef KST
#undef VST
}
#undef SBAR
}


#define XB_TMO      128
#define XB_XCNT(j)  (256  + 64 * (j))
#define XB_XSUB(j)  (1280 + 64 * (j))
#define XB_XGEN(j)  (2304 + 64 * (j))
#define XB_TOP      3328
#define XB_TOPGEN   3392
#define XCD_BAR_WORDS 3456
#define XB_SPIN_CAP (1u << 22)
__device__ __forceinline__ unsigned xb_ld(unsigned* p)              { return __hip_atomic_load(p, __ATOMIC_RELAXED, __HIP_MEMORY_SCOPE_AGENT); }
__device__ __forceinline__ unsigned xb_add(unsigned* p, unsigned v) { return __hip_atomic_fetch_add(p, v, __ATOMIC_RELAXED, __HIP_MEMORY_SCOPE_AGENT); }
__device__ __forceinline__ unsigned xb_xcc_id() { return (unsigned)__builtin_amdgcn_s_getreg((3 << 11) | 20) & 0xFu; }
#define XB_SPIN(cond, bar) do { unsigned _sp = 0; while (cond) { __builtin_amdgcn_s_sleep(1); \
    if ((++_sp & 255u) == 0u) { if (xb_ld(&(bar)[XB_TMO])) break; if (_sp > XB_SPIN_CAP) { atomicAdd(&(bar)[XB_TMO], 1u); break; } } } } while (0)
struct XcdBarrier { unsigned* bar; unsigned x; volatile LAS unsigned* st; };
__device__ __forceinline__ XcdBarrier xcd_barrier_post(unsigned* bar, volatile LAS unsigned* st, bool tid0) {
    XcdBarrier b; b.bar = bar; b.x = xb_xcc_id(); b.st = st;
    if (tid0) (void)xb_add(&bar[XB_XCNT(b.x)], 1u);
    return b;
}
__device__ __forceinline__ void xcd_barrier_complete(unsigned* bar, unsigned x, unsigned& nloc, unsigned& nx) {
    const unsigned G = gridDim.x * gridDim.y * gridDim.z;
    unsigned sum, cnt, mine, sp = 0u;
    for (;;) {
        sum = 0u; cnt = 0u; mine = 0u;
#pragma unroll
        for (unsigned j = 0; j < 16; ++j) { const unsigned c = xb_ld(&bar[XB_XCNT(j)]); sum += c; cnt += (c > 0u) ? 1u : 0u; mine = (j == x) ? c : mine; }
        if (sum == G) break;
        __builtin_amdgcn_s_sleep(1);
        if ((++sp & 255u) == 0u) { if (xb_ld(&bar[XB_TMO])) break; if (sp > XB_SPIN_CAP) { atomicAdd(&bar[XB_TMO], 1u); break; } }
    }
    nloc = mine > 0u ? mine : 1u; nx = cnt > 0u ? cnt : 1u;
}
__device__ __forceinline__ void xcd_barrier(const XcdBarrier& b, int wave_s) {
    asm volatile("s_waitcnt vmcnt(0)" ::: "memory");
    __syncthreads();
    if (tid_of(wave_s) == 0) {
        unsigned* bar = b.bar;
        __builtin_amdgcn_s_waitcnt(0);
        unsigned nloc = b.st[0], nx = b.st[1];
        if (nloc == 0u) { xcd_barrier_complete(bar, b.x, nloc, nx); b.st[0] = nloc; b.st[1] = nx; }
        const unsigned old = xb_add(&bar[XB_XSUB(b.x)], 1u);
        const unsigned gen = old / nloc;
        if (old + 1u == (gen + 1u) * nloc) {
            __builtin_amdgcn_fence(__ATOMIC_RELEASE, "agent");
            asm volatile("s_waitcnt vmcnt(0)" ::: "memory");
            const unsigned og = xb_add(&bar[XB_TOP], 1u);
            const unsigned tg = og / nx;
            if (og + 1u == (tg + 1u) * nx) xb_add(&bar[XB_TOPGEN], 1u);
            else XB_SPIN(xb_ld(&bar[XB_TOPGEN]) == tg, bar);
            __builtin_amdgcn_fence(__ATOMIC_ACQUIRE, "agent");
            xb_add(&bar[XB_XGEN(b.x)], 1u);
            asm volatile("s_waitcnt vmcnt(0)" ::: "memory");
        } else {
            XB_SPIN(xb_ld(&bar[XB_XGEN(b.x)]) == gen, bar);
            __builtin_amdgcn_fence(__ATOMIC_ACQUIRE, "agent");
            asm volatile("s_waitcnt vmcnt(0)" ::: "memory");
        }
    }
    __syncthreads();
}

constexpr int NWAVES = 8, NTHR = 512;
constexpr int LDS_BYTES = 147456;
constexpr int MISC_OFF = 146432;
static_assert(att::ATT_LDS <= MISC_OFF && pg8::STAGE_BYTES <= MISC_OFF && MISC_OFF + 16 <= LDS_BYTES, "LDS map");

struct Args {
    const float* x; const float* c; const float* w_ada; const float* b_ada; const float* norm1; const float* w_in; const float* a_q_norm; const float* a_k_norm;
    const float* b_q_norm; const float* b_kv_norm; const float* b_w_uq; const float* b_w_ukv; const float* c_sink; const float* d_lambda; const float* d_sub_norm;
    const float* w_out; const float* norm2; const float* w_ff1; const float* w_ff2; const float* rel_bias; const float* final_norm;
    float* out; unsigned char* ws;
};

__device__ __forceinline__ int perm128(int p) { const int half = p >> 6, w = p & 63; return half * 64 + (w >> 1) + 32 * (w & 1); }
__device__ __forceinline__ int perm64(int p) { return (p >> 1) + 32 * (p & 1); }
template <int MAP> __device__ __forceinline__ int srcmap(int nd, float& sc) {
    sc = 1.f;
    if (MAP == 0) return nd;
    if (MAP == 1) {
        if (nd >= INC) return -1;
        if (nd < C_AV) return (nd & ~127) + perm128(nd & 127);
        if (nd >= C_BKR && nd < C_CQ) return C_BKR + perm64(nd - C_BKR);
        if (nd >= C_CQ && nd < C_CK) sc = SC_A;
        if (nd >= C_DQ && nd < C_DK) sc = SC_D;
        return nd;
    }
    sc = SC_B; const int hd = nd / 192, p = nd % 192;
    return p < 128 ? nd : hd * 192 + 128 + perm64(p - 128);
}
template <int MAP>
__device__ __forceinline__ void transpose_item(const float* W, int K, int N, int Npad, bf16_t* WT, const float* gk, LAS float* scr, int item, int lane) {
    const int nblk = Npad / 32, kb = item / nblk, nb = item % nblk, k0 = 64 * kb, n0 = 32 * nb;
    float sc; const int ns = srcmap<MAP>(n0 + (lane & 31), sc);
    float wv[32];
    const float* Wp = W + (size_t)(k0 + (lane >> 5)) * N + (ns >= 0 ? ns : 0);
#pragma unroll
    for (int i = 0; i < 32; ++i) wv[i] = Wp[(size_t)(2 * i) * N];
#pragma unroll
    for (int i = 0; i < 32; ++i) { const int kk = 2 * i + (lane >> 5); float v = ns >= 0 ? wv[i] : 0.f; if (gk) v *= gk[k0 + kk]; scr[kk * 33 + (lane & 31)] = v * sc; }
    asm volatile("s_waitcnt lgkmcnt(0)" ::: "memory");
    const int c = lane & 7;
#pragma unroll
    for (int j = 0; j < 4; ++j) { const int n = (lane >> 3) + 8 * j; const LAS float* s = scr + (8 * c) * 33 + n;
        u32x4 o; o.x = pk2(s[0 * 33], s[1 * 33]); o.y = pk2(s[2 * 33], s[3 * 33]); o.z = pk2(s[4 * 33], s[5 * 33]); o.w = pk2(s[6 * 33], s[7 * 33]);
        *(u32x4*)(WT + (size_t)(n0 + n) * K + k0 + 8 * c) = o; }
    asm volatile("s_waitcnt lgkmcnt(0)" ::: "memory");
}
__device__ __forceinline__ int t5_bucket(int rel) {
    const int n = rel < 0 ? -rel : rel;
    int b = n < 8 ? n : min(15, 2 + (31 - __clz(n * n)));
    return b + (rel > 0 ? 16 : 0);
}

template <bool FINAL>
__device__ __forceinline__ void norm_pass(const float* X, const float* g, const float* scale, const float* shift, bf16_t* H, float* OUTF, int vcu_, int NGW_, int wave_s) {
    int vcu = vcu_, NGW = NGW_; asm volatile("" : "+s"(vcu), "+s"(NGW));
    int tid_ = tid_of(wave_s);
    const int lane = tid_ & 63, gw = vcu * NWAVES + wave_s;
    f32x4 gm[8], sh[8];
#pragma unroll
    for (int j = 0; j < 8; ++j) { const f32x4 gv = ((const f32x4*)g)[64 * j + lane];
        if (!FINAL) { const f32x4 s = ((const f32x4*)scale)[64 * j + lane]; gm[j] = gv * (1.f + s); sh[j] = ((const f32x4*)shift)[64 * j + lane]; } else { gm[j] = gv; sh[j] = (f32x4){0.f, 0.f, 0.f, 0.f}; } }
    f32x4 nv[8];
    { const f32x4* xr = (const f32x4*)(X + (size_t)gw * DM) + lane;
#pragma unroll
        for (int j = 0; j < 8; ++j) nv[j] = xr[64 * j]; }
    for (int m = gw; m < SEQ; m += NGW) {
        f32x4 v[8]; float ss = 0.f;
#pragma unroll
        for (int j = 0; j < 8; ++j) v[j] = nv[j];
        if (m + NGW < SEQ) { const f32x4* xn = (const f32x4*)(X + (size_t)(m + NGW) * DM) + lane;
#pragma unroll
            for (int j = 0; j < 8; ++j) nv[j] = xn[64 * j]; }
#pragma unroll
        for (int j = 0; j < 8; ++j) ss += (v[j].x * v[j].x + v[j].y * v[j].y) + (v[j].z * v[j].z + v[j].w * v[j].w);
        const float rstd = 1.0f / sqrtf(wave_sum(ss) * (1.f / DM) + EPS);
        if (FINAL) { f32x4* orow = (f32x4*)(OUTF + (size_t)m * DM) + lane;
#pragma unroll
            for (int j = 0; j < 8; ++j) orow[64 * j] = v[j] * rstd * gm[j]; }
        else { u32x2* orow = (u32x2*)(H + (size_t)m * DM) + lane;
#pragma unroll
            for (int j = 0; j < 8; ++j) { const f32x4 y = v[j] * rstd * gm[j] + sh[j]; u32x2 w; w.x = pk2(y.x, y.y); w.y = pk2(y.z, y.w); orow[64 * j] = w; } }
    }
}


__device__ __forceinline__ void store_o_tile(const f32x16 (&o)[4], char* lds, bf16_t* Og, int wave_s) {
    int tid_ = tid_of(wave_s);
    const int wid = tid_ >> 6, lane = tid_ & 63, r32 = lane & 31, hi = lane >> 5;
    __syncthreads();
    bf16_t* stg = (bf16_t*)(lds + wid * 8192);
#pragma unroll
    for (int r = 0; r < 16; ++r) { const int orow = att::crow(r, hi);
#pragma unroll
        for (int d0 = 0; d0 < 4; ++d0) stg[orow * 128 + d0 * 32 + r32] = (bf16_t)f2bf(o[d0][r]); }
    asm volatile("s_waitcnt lgkmcnt(0)" ::: "memory");
#pragma unroll
    for (int i = 0; i < 8; ++i) { const int row = i * 4 + (lane >> 4), ch = lane & 15; const u32x4 v = *(const u32x4*)(stg + row * 128 + ch * 8); *(u32x4*)(Og + (size_t)row * DM + ch * 8) = v;
        if (i & 1) asm volatile("" ::: "memory"); }
    asm volatile("s_waitcnt lgkmcnt(0)" ::: "memory");
}

__global__ void __launch_bounds__(NTHR, 2) mega_fwd(Args a) {
    extern __shared__ __attribute__((aligned(16))) unsigned char lds[];
    cg::grid_group grid = cg::this_grid();
    const int wave_s = __builtin_amdgcn_readfirstlane((int)threadIdx.x >> 6);
    const int tid = tid_of(wave_s), lane = tid & 63, wave = wave_s;
    const int G = gridDim.x, bx = blockIdx.x;
    const int vcu = (G % 8 == 0) ? (bx % 8) * (G / 8) + bx / 8 : bx;
    const int gw = vcu * NWAVES + wave, NGW = G * NWAVES;
#define PH unsigned char* ws = a.ws; asm volatile("" : "+s"(ws)); int lq = l; asm volatile("" : "+s"(lq)); (void)lq;
#define LAM ((float*)(ws + WS_CTL))
#define SMV ((float*)(ws + WS_SMALL))
#define MOD ((float*)(ws + WS_MOD))
#define TAB ((f32x2*)(ws + WS_TAB))
#define RS ((float*)(ws + WS_RS))
#define WIN ((bf16_t*)(ws + WS_WIN))
#define WUQ ((bf16_t*)(ws + WS_WUQ))
#define WUKV ((bf16_t*)(ws + WS_WUKV))
#define WOUT ((bf16_t*)(ws + WS_WOUT))
#define WFF1 ((bf16_t*)(ws + WS_WFF1))
#define WFF2 ((bf16_t*)(ws + WS_WFF2))
#define H ((bf16_t*)(ws + WS_H))
#define DSCR ((float*)(ws + WS_DSCR))
#define P ((bf16_t*)(ws + WS_P))
#define QB ((bf16_t*)(ws + WS_QB))
#define KVB ((bf16_t*)(ws + WS_KVB))
#define O ((bf16_t*)(ws + WS_O))
#define HID ((bf16_t*)(ws + WS_HID))
    LAS unsigned char* ldsl = (LAS unsigned char*)lds;

    {
        const int l = 0; PH
        LAS float* scr = (LAS float*)(ldsl + wave * 16384);
        constexpr int I_IN = (DM / 64) * (INP / 32), I_UQ = (384 / 64) * (768 / 32), I_UKV = (256 / 64) * (1024 / 32), I_OUT = (DM / 64) * (DM / 32), I_F1 = (DM / 64) * (DFF / 32), I_F2 = (DFF / 64) * (DM / 32);
        constexpr int I_L = I_IN + I_UQ + I_UKV + I_OUT + I_F1 + I_F2;
        for (int it = gw; it < NLAYER * I_L; it += NGW) {
            const int l = it / I_L; int r = it % I_L;
            if (r < I_IN) { transpose_item<1>(a.w_in + (size_t)l * DM * INC, DM, INC, INP, WIN + (size_t)l * INP * DM, nullptr, scr, r, lane); continue; } r -= I_IN;
            if (r < I_UQ) { transpose_item<2>(a.b_w_uq + (size_t)l * 384 * 768, 384, 768, 768, WUQ + (size_t)l * 768 * 384, a.b_q_norm + l * 384, scr, r, lane); continue; } r -= I_UQ;
            if (r < I_UKV) { transpose_item<0>(a.b_w_ukv + (size_t)l * 256 * 1024, 256, 1024, 1024, WUKV + (size_t)l * 1024 * 256, a.b_kv_norm + l * 256, scr, r, lane); continue; } r -= I_UKV;
            if (r < I_OUT) { transpose_item<0>(a.w_out + (size_t)l * DM * DM, DM, DM, DM, WOUT + (size_t)l * DM * DM, nullptr, scr, r, lane); continue; } r -= I_OUT;
            if (r < I_F1) { transpose_item<0>(a.w_ff1 + (size_t)l * DM * DFF, DM, DFF, DFF, WFF1 + (size_t)l * DFF * DM, nullptr, scr, r, lane); continue; } r -= I_F1;
            transpose_item<0>(a.w_ff2 + (size_t)l * DFF * DM, DFF, DM, DM, WFF2 + (size_t)l * DM * DFF, nullptr, scr, r, lane);
        }
        for (int e = bx * NTHR + tid; e < SEQ * 32; e += G * NTHR) {
            const int pos = e >> 5, i = e & 31;
            const float inv = (float)exp2(-(double)i * (13.287712379549449 / 32.0));
            const float ang = (float)pos * inv;
            const double rev = (double)ang * 0.15915494309189535; const float fr = (float)(rev - rint(rev));
            TAB[e] = (f32x2){__builtin_amdgcn_cosf(fr), __builtin_amdgcn_sinf(fr)};
        }
        if (bx == 0) { float* sm = SMV;
            for (int i = tid; i < 4096; i += NTHR) { sm[SM_N1 + i] = a.norm1[i]; sm[SM_N2 + i] = a.norm2[i]; }
            for (int i = tid; i < 2048; i += NTHR) sm[SM_FN + i] = a.final_norm[i];
            if (tid < 256) { sm[SM_AQ + tid] = a.a_q_norm[tid]; sm[SM_AK + tid] = a.a_k_norm[tid]; sm[SM_DS + tid] = a.d_sub_norm[tid]; sm[SM_RB + tid] = a.rel_bias[tid]; }
            if (tid < 8) sm[SM_CS + tid] = a.c_sink[tid]; }
        if (bx == 0) for (int i = tid; i < XCD_BAR_WORDS; i += NTHR) ((unsigned*)(ws + WS_BAR))[i] = 0u;
        if (tid < 4) ((LAS unsigned*)(ldsl + MISC_OFF))[tid] = 0u;
        if (bx == 0 && wave == 0) {
            for (int l = 0; l < NLAYER; ++l) { const float* lf = a.d_lambda + l * 256;
                const float sa = wave_sum(lf[lane] * lf[64 + lane]), sb = wave_sum(lf[128 + lane] * lf[192 + lane]);
                const float lam_init = 0.8f - 0.6f * expf(-0.3f * (float)l);
                if (lane == 0) LAM[l] = expf(sa) - expf(sb) + lam_init; }
        }
        __syncthreads();
        LAS float* red = (LAS float*)ldsl;
        for (int ch = bx; ch < NLAYER * 192; ch += G) {
            const int l = ch / 192, n0 = (ch % 192) * 64; const float* W = a.w_ada + (size_t)l * DM * 12288;
            const int cg4 = lane & 15, ksub = lane >> 4; f32x4 acc = {0.f, 0.f, 0.f, 0.f};
#pragma unroll 16
            for (int kk = 0; kk < 64; ++kk) { const int k = wave * 256 + kk * 4 + ksub; const float cv = a.c[k]; const float sv = cv / (1.f + expf(-cv));
                const f32x4 w = *(const f32x4*)(W + (size_t)k * 12288 + n0 + cg4 * 4); acc += w * sv; }
#pragma unroll
            for (int e = 0; e < 4; ++e) { acc[e] += swz_xor<16>(acc[e]); auto rr = __builtin_amdgcn_permlane32_swap(__float_as_uint(acc[e]), __float_as_uint(acc[e]), false, false); acc[e] = __uint_as_float(rr[0]) + __uint_as_float(rr[1]); }
            if (ksub == 0) { red[wave * 64 + cg4 * 4 + 0] = acc[0]; red[wave * 64 + cg4 * 4 + 1] = acc[1]; red[wave * 64 + cg4 * 4 + 2] = acc[2]; red[wave * 64 + cg4 * 4 + 3] = acc[3]; }
            __syncthreads();
            if (tid < 64) { float s = 0.f;
#pragma unroll
                for (int w = 0; w < 8; ++w) s += red[w * 64 + tid];
                MOD[l * 12288 + n0 + tid] = s + a.b_ada[l * 12288 + n0 + tid]; }
            __syncthreads();
        }
    }
    grid.sync();
    (void)xcd_barrier_post((unsigned*)(a.ws + WS_BAR), (volatile LAS unsigned*)(ldsl + MISC_OFF), tid_of(wave_s) == 0);
#define GRID_BAR() do { unsigned char* wsb = a.ws; asm volatile("" : "+s"(wsb)); XcdBarrier xb_; xb_.bar = (unsigned*)(wsb + WS_BAR); xb_.x = xb_xcc_id(); xb_.st = (volatile LAS unsigned*)(ldsl + MISC_OFF); xcd_barrier(xb_, wave_s); } while (0)

    for (int l = 0; l < NLAYER; ++l) {
        const int tid = tid_of(wave_s), lane = tid & 63, wave = wave_s, gw = vcu * NWAVES + wave;
        { PH const float* mod = MOD + lq * 12288; norm_pass<false>((lq == 0) ? a.x : a.out, SMV + SM_N1 + lq * DM, mod + 1 * DM, mod + 0 * DM, H, nullptr, vcu, NGW, wave_s); }
        GRID_BAR();
        { PH pg8::Gemm g{H, WIN + (size_t)lq * INP * DM, SEQ, INP, DM, DM}; pg8::StaticOrder S; S.init(SEQ, INP, G, bx);
          pg8::EpiBf16<0> E{P, INP, nullptr, nullptr}; pg8::gemm_phase(ldsl, g, S, E, wave_s); }
        GRID_BAR();
        { PH
            const float* gq = SMV + SM_AQ + lq * 128; const float* gk = SMV + SM_AK + lq * 128;
            const int p0i = perm128(2 * lane), p1i = perm128(2 * lane + 1);
            const float gq0 = gq[p0i], gq1 = gq[p1i], gk0 = gk[p0i], gk1 = gk[p1i];
            for (int t = gw; t < SEQ; t += NGW) {
                bf16_t* row = P + (size_t)t * INP;
                unsigned w[12];
#pragma unroll
                for (int hd = 0; hd < 6; ++hd) w[hd] = ((const unsigned*)(row + hd * 128))[lane];
                w[6] = ((const unsigned*)(row + C_BKR))[lane & 31];
#pragma unroll
                for (int j = 0; j < 3; ++j) w[7 + j] = ((const unsigned*)(row + C_BCQ))[lane + 64 * j];
#pragma unroll
                for (int j = 0; j < 2; ++j) w[10 + j] = ((const unsigned*)(row + C_BCKV))[lane + 64 * j];
                const int pos = lane < 32 ? (t >> 6) : (t & 63); const f32x2 cs = TAB[pos * 32 + (lane & 31)], c2 = TAB[t * 32 + (lane & 31)];
#pragma unroll
                for (int hd = 0; hd < 6; ++hd) {
                    float x0 = bf2f((unsigned short)(w[hd] & 0xffff)), x1 = bf2f((unsigned short)(w[hd] >> 16));
                    const float rstd = 1.0f / sqrtf(wave_sum(x0 * x0 + x1 * x1) * (1.f / 128.f) + EPS);
                    const float qs = hd < 4 ? SC_A : 1.f;
                    x0 *= rstd * (hd < 4 ? gq0 : gk0) * qs; x1 *= rstd * (hd < 4 ? gq1 : gk1) * qs;
                    ((unsigned*)(row + hd * 128))[lane] = pk2(x0 * cs.x - x1 * cs.y, x1 * cs.x + x0 * cs.y); }
                if (lane < 32) { const float x0 = bf2f((unsigned short)(w[6] & 0xffff)), x1 = bf2f((unsigned short)(w[6] >> 16));
                    ((unsigned*)(row + C_BKR))[lane] = pk2(x0 * c2.x - x1 * c2.y, x1 * c2.x + x0 * c2.y); }
                float sq = 0.f, skv = 0.f;
#pragma unroll
                for (int j = 0; j < 3; ++j) { const float x0 = bf2f((unsigned short)(w[7 + j] & 0xffff)), x1 = bf2f((unsigned short)(w[7 + j] >> 16)); sq += x0 * x0 + x1 * x1; }
#pragma unroll
                for (int j = 0; j < 2; ++j) { const float x0 = bf2f((unsigned short)(w[10 + j] & 0xffff)), x1 = bf2f((unsigned short)(w[10 + j] >> 16)); skv += x0 * x0 + x1 * x1; }
                sq = wave_sum(sq); skv = wave_sum(skv);
                if (lane == 0) { RS[t] = 1.0f / sqrtf(sq * (1.f / 384.f) + EPS); RS[SEQ + t] = 1.0f / sqrtf(skv * (1.f / 256.f) + EPS); }
            }
        }
        GRID_BAR();
        { PH pg8::Gemm g{P + C_BCQ, WUQ + (size_t)lq * 768 * 384, SEQ, 768, 384, INP}; pg8::StaticOrder S; S.init(SEQ, 768, G, bx);
          pg8::EpiBf16<3> E{QB, 768, RS, TAB}; pg8::gemm_phase(ldsl, g, S, E, wave_s); }
        { PH pg8::Gemm g{P + C_BCKV, WUKV + (size_t)lq * 1024 * 256, SEQ, 1024, 256, INP}; pg8::StaticOrder S; S.init(SEQ, 1024, G, bx);
          pg8::EpiBf16<2> E{KVB, 1024, RS + SEQ, nullptr}; pg8::gemm_phase(ldsl, g, S, E, wave_s); }
        GRID_BAR();
        for (int u = vcu; u < 256; u += G) { PH
            const int hd = u >> 6, blk = u & 63, q0 = blk * 256;
            f32x16 o[4];
#define UNIT_IDS int tidu = tid_of(wave_s); const int wid = tidu >> 6, lane = tidu & 63, r32 = lane & 31, tid = tidu; (void)r32; (void)tid;
            float* lut = (float*)(lds + att::OFF_LUT);
            { UNIT_IDS att::attn_core<8, 0>(P + (size_t)q0 * INP + C_AQ + hd * 128, INP, P + C_AK + (hd >> 1) * 128, INP, nullptr, 0, P + C_AV + (hd >> 1) * 128, INP, 0, SEQ / 64, q0, nullptr, 0.f, 0.f, 0.f, 0.f, (char*)lds, o, wave_s);
              store_o_tile(o, (char*)lds, O + (size_t)(q0 + wid * 32) * DM + (0 + hd) * 128, wave_s); }
            { UNIT_IDS att::attn_core<12, 0>(QB + (size_t)q0 * 768 + hd * 192, 768, KVB + hd * 256, 1024, P + C_BKR, INP, KVB + hd * 256 + 128, 1024, 0, SEQ / 64, q0, nullptr, 0.f, 0.f, 0.f, 0.f, (char*)lds, o, wave_s);
              store_o_tile(o, (char*)lds, O + (size_t)(q0 + wid * 32) * DM + (4 + hd) * 128, wave_s); }
            { UNIT_IDS __syncthreads();
              if (tid < 257) lut[tid] = SMV[SM_RB + t5_bucket(tid - 128) * 8 + hd] * LOG2E;
              const int ks = q0 - 128 < 0 ? 0 : q0 - 128, ke = q0 + 384 > SEQ ? SEQ : q0 + 384;
              const float sink = SMV[SM_CS + lq * 4 + hd] * LOG2E;
              att::attn_core<8, 2>(P + (size_t)q0 * INP + C_CQ + hd * 128, INP, P + C_CK + (hd >> 1) * 128, INP, nullptr, 0, P + C_CV + (hd >> 1) * 128, INP, ks / 64, (ke - ks) / 64, q0, lut, 0.f, 0.f, sink, 1.f, (char*)lds, o, wave_s);
              store_o_tile(o, (char*)lds, O + (size_t)(q0 + wid * 32) * DM + (8 + hd) * 128, wave_s); }
            { UNIT_IDS __syncthreads();
              if (tid < 257) lut[tid] = SMV[SM_RB + t5_bucket(tid - 128) * 8 + 4 + hd] * LOG2E;
              const float cbL = SMV[SM_RB + 15 * 8 + 4 + hd] * LOG2E, cbR = SMV[SM_RB + 31 * 8 + 4 + hd] * LOG2E;
              att::attn_core<4, 1>(P + (size_t)q0 * INP + C_DQ + hd * 128, INP, P + C_DK + hd * 128, INP, nullptr, 0, P + C_DV + hd * 128, INP, 0, SEQ / 64, q0, lut, cbL, cbR, 0.f, 0.f, (char*)lds, o, wave_s);
              { float* scrp = DSCR + ((size_t)(u * 8 + wave_s) * 64) * 64 + (tid_of(wave_s) & 63);
#pragma unroll
              for (int d0 = 0; d0 < 4; ++d0)
#pragma unroll
                  for (int r = 0; r < 16; ++r) scrp[(d0 * 16 + r) * 64] = o[d0][r]; }
              att::attn_core<4, 1>(P + (size_t)q0 * INP + C_DQ + hd * 128 + 64, INP, P + C_DK + hd * 128 + 64, INP, nullptr, 0, P + C_DV + hd * 128, INP, 0, SEQ / 64, q0, lut, cbL, cbR, 0.f, 0.f, (char*)lds, o, wave_s);
              const int lane2 = tid_of(wave_s) & 63, r32b = lane2 & 31;
              const float* scrq = DSCR + ((size_t)(u * 8 + wave_s) * 64) * 64 + lane2; asm volatile("" : "+v"(scrq) :: "memory");
              const float lam = LAM[lq]; const float* gs = SMV + SM_DS + lq * 128; const float post = 1.f - (0.8f - 0.6f * expf(-0.3f * (float)lq));
              float gv[4];
#pragma unroll
              for (int d0 = 0; d0 < 4; ++d0) gv[d0] = gs[d0 * 32 + r32b] * post;
#pragma unroll
              for (int r = 0; r < 16; ++r) { float ss = 0.f;
#pragma unroll
                  for (int d0 = 0; d0 < 4; ++d0) { const float dv = scrq[(d0 * 16 + r) * 64] - lam * o[d0][r]; o[d0][r] = dv; ss += dv * dv; }
                  ss = half_sum(ss);
                  const float rstd = 1.0f / sqrtf(ss * (1.f / 128.f) + EPS);
#pragma unroll
                  for (int d0 = 0; d0 < 4; ++d0) o[d0][r] *= rstd * gv[d0];
                  if ((r & 3) == 3) asm volatile("" ::: "memory"); }
              store_o_tile(o, (char*)lds, O + (size_t)(q0 + wid * 32) * DM + (12 + hd) * 128, wave_s); }
        }
        GRID_BAR();
        { PH pg8::Gemm g{O, WOUT + (size_t)lq * DM * DM, SEQ, DM, DM, DM}; pg8::StaticOrder S; S.init(SEQ, DM, G, bx);
          pg8::EpiRes E{(lq == 0) ? a.x : a.out, a.out, MOD + lq * 12288 + 2 * DM, DM}; pg8::gemm_phase(ldsl, g, S, E, wave_s); }
        GRID_BAR();
        { PH const float* mod = MOD + lq * 12288; norm_pass<false>(a.out, SMV + SM_N2 + lq * DM, mod + 4 * DM, mod + 3 * DM, H, nullptr, vcu, NGW, wave_s); }
        GRID_BAR();
        { PH pg8::Gemm g{H, WFF1 + (size_t)lq * DFF * DM, SEQ, DFF, DM, DM}; pg8::StaticOrder S; S.init(SEQ, DFF, G, bx);
          pg8::EpiBf16<1> E{HID, DFF, nullptr, nullptr}; pg8::gemm_phase(ldsl, g, S, E, wave_s); }
        GRID_BAR();
        { PH pg8::Gemm g{HID, WFF2 + (size_t)lq * DM * DFF, SEQ, DM, DFF, DFF}; pg8::StaticOrder S; S.init(SEQ, DM, G, bx);
          pg8::EpiRes E{a.out, a.out, MOD + lq * 12288 + 5 * DM, DM}; pg8::gemm_phase(ldsl, g, S, E, wave_s); }
        GRID_BAR();
    }
    { const int l = 0; PH norm_pass<true>(a.out, SMV + SM_FN, nullptr, nullptr, nullptr, a.out, vcu, NGW, wave_s); }
}

extern "C" void kernel_launch(void* const* d_in, const int* in_sizes, int n_in, void* d_out, int out_size, void* d_ws, size_t ws_size, hipStream_t stream) {
    static int grid = 0;
    if (grid == 0) {
        if (n_in != 21 || out_size != SEQ * DM || ws_size < WS_END) { fprintf(stderr, "kernel_launch: unexpected shapes (n_in %d out %d ws %zu)\n", n_in, out_size, ws_size); grid = -1; return; }
        int dev = 0, cus = 0, per_cu = 0;
        hipGetDevice(&dev); hipDeviceGetAttribute(&cus, hipDeviceAttributeMultiprocessorCount, dev);
        if (hipFuncSetAttribute((const void*)mega_fwd, hipFuncAttributeMaxDynamicSharedMemorySize, LDS_BYTES) != hipSuccess) { fprintf(stderr, "kernel_launch: hipFuncSetAttribute failed\n"); grid = -1; return; }
        if (hipOccupancyMaxActiveBlocksPerMultiprocessor(&per_cu, (const void*)mega_fwd, NTHR, LDS_BYTES) != hipSuccess || per_cu < 1) { fprintf(stderr, "kernel_launch: occupancy query gave %d\n", per_cu); per_cu = 1; }
        (void)hipGetLastError();
        grid = cus * 1;
    }
    if (grid < 0) return;
    Args a{};
    const float** f = (const float**)&a;
    for (int i = 0; i < 21; ++i) f[i] = (const float*)d_in[i];
    a.out = (float*)d_out; a.ws = (unsigned char*)d_ws;
    void* args[] = {&a};
    hipError_t e = hipLaunchCooperativeKernel((const void*)mega_fwd, dim3(grid), dim3(NTHR), args, LDS_BYTES, stream);
    if (e != hipSuccess) fprintf(stderr, "cooperative launch failed: %s (grid %d)\n", hipGetErrorString(e), grid);
}
```
